# Optimizing an MI355X kernel written in HIP

```python
import jax, jax.numpy as jnp
from jax import lax
import numpy as np

D_MODEL = 2048
BATCH = 2
SEQ = 8192
DEPTH = 4

PLE_DIM = 256
EPS = 1e-6
MIX = D_MODEL

CHUNK = 128
A_HEAD = 128
A_WIDTH = MIX // 4
A_HEADS = A_WIDTH // A_HEAD

B_GROUP = 128
B_WIDTH = MIX // 4
B_GROUPS = B_WIDTH // B_GROUP
CONV_W = 3

C_WIDTH = MIX - A_WIDTH - B_WIDTH
C_V = 128
C_HEADS = C_WIDTH // C_V
C_NOPE = 128
C_ROPE = 64
KV_RANK = 512
ROPE_BASE = 10000.0
Q_BLOCK = 128

IN_SPLITS = (A_WIDTH, A_WIDTH, A_WIDTH,
             B_WIDTH, B_WIDTH, B_WIDTH, B_WIDTH,
             C_HEADS * (C_NOPE + C_ROPE), KV_RANK, C_ROPE, C_WIDTH)
IN_WIDTH = 3 * A_WIDTH + 4 * B_WIDTH + C_HEADS * (C_NOPE + C_ROPE) + KV_RANK + C_ROPE + C_WIDTH

kernel_name = 'hybrid_sgu_shortconv_mla_encoder'


def rms_norm(x, g):
    x32 = x.astype(jnp.float32)
    y = x32 * lax.rsqrt(jnp.mean(x32 * x32, axis=-1, keepdims=True) + EPS)
    return y.astype(x.dtype) * g


def rope_tables(positions):
    inv = 1.0 / (ROPE_BASE ** (jnp.arange(0, C_ROPE, 2, dtype=jnp.float32) / C_ROPE))
    ang = positions.astype(jnp.float32)[..., None] * inv
    return jnp.cos(ang), jnp.sin(ang)


def apply_rope(x, cos, sin):
    half = x.shape[-1] // 2
    x1, x2 = x[..., :half], x[..., half:]
    out = jnp.concatenate([x1 * cos - x2 * sin, x2 * cos + x1 * sin], axis=-1)
    return out.astype(x.dtype)


def spatial_gating(u, v, z, v_gain, w_s, b_s):
    bsz, s_len, _ = u.shape
    v = rms_norm(v.reshape(bsz, s_len, A_HEADS, A_HEAD), v_gain)
    vc = v.reshape(bsz, s_len // CHUNK, CHUNK, A_HEADS, A_HEAD)
    s = jnp.einsum('hnm,bkmhc->bknhc', w_s, vc) + b_s.T[None, None, :, :, None]
    return u * s.reshape(bsz, s_len, A_WIDTH) * jax.nn.silu(z)


def short_conv(gate_b, gate_c, h, z, conv_w, conv_b):
    s_len = h.shape[1]
    pad = CONV_W // 2
    xp = jnp.pad(gate_c * h, ((0, 0), (pad, pad), (0, 0)))
    y = conv_b + sum(xp[:, j:j + s_len] * conv_w[j] for j in range(CONV_W))
    return gate_b * y * jax.nn.silu(z)


def latent_attention(q, c_kv, k_rope, z, cos, sin, kv_gain, w_ukv, qn_g, qr_g, kn_g, kr_g):
    bsz, s_len, _ = q.shape
    q = q.reshape(bsz, s_len, C_HEADS, C_NOPE + C_ROPE)
    q_nope = rms_norm(q[..., :C_NOPE], qn_g)
    q_rope = apply_rope(rms_norm(q[..., C_NOPE:], qr_g), cos[:, :, None], sin[:, :, None])
    kv = (rms_norm(c_kv, kv_gain) @ w_ukv).reshape(bsz, s_len, C_HEADS, C_NOPE + C_V)
    k_nope = rms_norm(kv[..., :C_NOPE], kn_g)
    v = kv[..., C_NOPE:]
    k_r = apply_rope(rms_norm(k_rope, kr_g), cos, sin)
    scale = (C_NOPE + C_ROPE) ** -0.5
    n_blk = s_len // Q_BLOCK

    def to_blocks(t):
        return jnp.moveaxis(t.reshape(bsz, n_blk, Q_BLOCK, *t.shape[2:]), 1, 0)

    def attend(blk):
        qn, qr = blk
        s = jnp.einsum('bqhd,bkhd->bhqk', qn, k_nope) + jnp.einsum('bqhr,bkr->bhqk', qr, k_r)
        w = jax.nn.softmax(s.astype(jnp.float32) * scale, axis=-1).astype(v.dtype)
        return jnp.einsum('bhqk,bkhd->bqhd', w, v)

    o = lax.map(attend, (to_blocks(q_nope), to_blocks(q_rope)))
    o = jnp.moveaxis(o, 0, 1).reshape(bsz, s_len, C_WIDTH)
    return o * jax.nn.silu(z)


def setup_inputs(seed: int = 0) -> dict:
    key = jax.random.key(seed)
    ks = jax.random.split(key, 24)
    f32 = jnp.float32

    def nrm(k, shape, scale):
        return jax.random.normal(k, shape, f32) * scale

    def gain(k, shape):
        return 1.0 + 0.01 * jax.random.normal(k, shape, f32)

    return {
        'x': jax.random.normal(ks[0], (BATCH, SEQ, D_MODEL), f32),
        'p': jax.random.normal(ks[1], (DEPTH, BATCH, SEQ, PLE_DIM), f32),
        'positions': jnp.broadcast_to(jnp.arange(SEQ, dtype=jnp.int32), (BATCH, SEQ)),
        'attn_norm': gain(ks[2], (DEPTH, D_MODEL)),
        'w_in': nrm(ks[3], (DEPTH, D_MODEL, IN_WIDTH), D_MODEL ** -0.5),
        'sgu_norm': gain(ks[4], (DEPTH, A_HEADS, A_HEAD)),
        'w_spatial': nrm(ks[5], (DEPTH, A_HEADS, CHUNK, CHUNK), CHUNK ** -0.5),
        'b_spatial': gain(ks[6], (DEPTH, A_HEADS, CHUNK)),
        'conv_w': nrm(ks[7], (DEPTH, CONV_W, B_WIDTH), CONV_W ** -0.5),
        'conv_b': nrm(ks[8], (DEPTH, B_WIDTH), 0.01),
        'kv_norm': gain(ks[9], (DEPTH, KV_RANK)),
        'w_ukv': nrm(ks[10], (DEPTH, KV_RANK, C_HEADS * (C_NOPE + C_V)), KV_RANK ** -0.5),
        'q_nope_norm': gain(ks[11], (DEPTH, C_NOPE)),
        'q_rope_norm': gain(ks[12], (DEPTH, C_ROPE)),
        'k_nope_norm': gain(ks[13], (DEPTH, C_NOPE)),
        'k_rope_norm': gain(ks[14], (DEPTH, C_ROPE)),
        'out_norm': gain(ks[15], (DEPTH, MIX)),
        'w_out': nrm(ks[16], (DEPTH, MIX, D_MODEL), MIX ** -0.5),
        'ple_norm': gain(ks[17], (DEPTH, D_MODEL)),
        'w_ple_gate': nrm(ks[18], (DEPTH, D_MODEL, D_MODEL), D_MODEL ** -0.5),
        'w_ple_proj': nrm(ks[19], (DEPTH, PLE_DIM, D_MODEL), PLE_DIM ** -0.5),
    }


def reference(x, p, positions, attn_norm, w_in, sgu_norm, w_spatial, b_spatial, conv_w, conv_b,
              kv_norm, w_ukv, q_nope_norm, q_rope_norm, k_nope_norm, k_rope_norm,
              out_norm, w_out, ple_norm, w_ple_gate, w_ple_proj):
    cos, sin = rope_tables(positions)
    split_pts = [int(c) for c in np.cumsum(IN_SPLITS)[:-1]]
    out_pts = [A_WIDTH, A_WIDTH + B_WIDTH]
    h = x
    for i in range(DEPTH):
        hn = rms_norm(h, attn_norm[i])
        proj = hn @ w_in[i]
        (a_u, a_v, a_z, b_b, b_c, b_h, b_z, c_q, c_kv, c_kr, c_z) = jnp.split(proj, split_pts, axis=-1)
        y_a = spatial_gating(a_u, a_v, a_z, sgu_norm[i], w_spatial[i], b_spatial[i])
        y_b = short_conv(b_b, b_c, b_h, b_z, conv_w[i], conv_b[i])
        y_c = latent_attention(c_q, c_kv, c_kr, c_z, cos, sin, kv_norm[i], w_ukv[i],
                               q_nope_norm[i], q_rope_norm[i], k_nope_norm[i], k_rope_norm[i])
        g_a, g_b, g_c = jnp.split(out_norm[i], out_pts)
        y = jnp.concatenate([rms_norm(y_a, g_a), rms_norm(y_b, g_b), rms_norm(y_c, g_c)], axis=-1)
        h = h + y @ w_out[i]
        gate = jax.nn.sigmoid(rms_norm(h, ple_norm[i]) @ w_ple_gate[i])
        h = h + gate * (p[i] @ w_ple_proj[i])
    return h
```

```cpp
#include <hip/hip_runtime.h>
#include <hip/hip_cooperative_groups.h>
#include <cstdio>
#include <cstdint>
namespace cg = cooperative_groups;

constexpr int D_MODEL = 2048, BATCH = 2, SEQ = 8192, DEPTH = 4, T = BATCH * SEQ;
constexpr int PLE = 256, IN_W = 6720, LDP = 6912  ;
constexpr int OFF_AU = 0, OFF_AV = 512, OFF_AZ = 1024, OFF_BB = 1536, OFF_BC = 2048, OFF_BH = 2560, OFF_BZ = 3072,
              OFF_CQ = 3584, OFF_CKV = 5120, OFF_CKR = 5632, OFF_CZ = 5696;
constexpr float EPS = 1e-6f;
constexpr int NTHR = 512;
constexpr int YC = 0, YA = 1024, YB = 1536;

typedef unsigned short bf16_t;
typedef short bf16x8 __attribute__((ext_vector_type(8)));
typedef short s16x4 __attribute__((ext_vector_type(4)));
typedef float f32x4 __attribute__((ext_vector_type(4)));
typedef float f32x16 __attribute__((ext_vector_type(16)));
typedef unsigned u32x4 __attribute__((ext_vector_type(4)));
typedef unsigned u32x2 __attribute__((ext_vector_type(2)));

constexpr size_t SZ_WT_IN = (size_t)DEPTH * LDP * 2048 * 2, SZ_WT_UKV = (size_t)DEPTH * 2048 * 512 * 2, SZ_WT_SQ = (size_t)DEPTH * 2048 * 2048 * 2,
                 SZ_WT_PP = (size_t)DEPTH * 2048 * 256 * 2, SZ_PB = (size_t)DEPTH * T * 256 * 2, SZ_ACT = (size_t)T * 2048 * 2,
                 SZ_PROJ = (size_t)T * LDP * 2, SZ_CKVN = (size_t)T * 512 * 2, SZ_QK = (size_t)BATCH * 8 * SEQ * 192 * 2, SZ_ROPE = (size_t)T * 32 * 4;
constexpr size_t WS_WT_IN = 0, WS_WT_UKV = WS_WT_IN + SZ_WT_IN, WS_WT_OUT = WS_WT_UKV + SZ_WT_UKV, WS_WT_G = WS_WT_OUT + SZ_WT_SQ,
                 WS_WT_PP = WS_WT_G + SZ_WT_SQ, WS_PB = WS_WT_PP + SZ_WT_PP, WS_Y = WS_PB + SZ_PB  , WS_PROJ = WS_Y + SZ_ACT,
                 WS_PP = WS_PROJ + SZ_PROJ, WS_CKVN = WS_PP + SZ_ACT, WS_KV = WS_CKVN + SZ_CKVN, WS_Q = WS_KV + SZ_ACT, WS_K = WS_Q + SZ_QK,
                 WS_COS = WS_K + SZ_QK, WS_SIN = WS_COS + SZ_ROPE, WS_BAR = WS_SIN + SZ_ROPE, WS_SSQA = WS_BAR + 16384, WS_SSQC = WS_SSQA + (size_t)T * 4 * 4, WS_SSQ2 = WS_SSQC + (size_t)T * 8 * 4, WS_END = WS_SSQ2 + (size_t)T * 32 * 4;

struct Params {
    const float* x; const float* p; const int* positions; const float* attn_norm; const float* w_in; const float* sgu_norm; const float* w_spatial;
    const float* b_spatial; const float* conv_w; const float* conv_b; const float* kv_norm; const float* w_ukv; const float* q_nope_norm;
    const float* q_rope_norm; const float* k_nope_norm; const float* k_rope_norm; const float* out_norm; const float* w_out; const float* ple_norm;
    const float* w_ple_gate; const float* w_ple_proj; float* out; unsigned char* ws;
};

typedef const __attribute__((address_space(4))) Params* KPtr;
__device__ __forceinline__ KPtr kp_fresh() { KPtr k = (KPtr)__builtin_amdgcn_kernarg_segment_ptr(); asm volatile("" : "+s"(k)); return k; }
__device__ __forceinline__ int otid(int wv) { unsigned z = 0u; asm volatile("" : "+v"(z)); return (int)__builtin_amdgcn_mbcnt_hi(~0u, __builtin_amdgcn_mbcnt_lo(~0u, z)) + 64 * wv; }
__device__ __forceinline__ float bf2f(bf16_t u) { return __uint_as_float(((unsigned)u) << 16); }
__device__ __forceinline__ float bflo(unsigned w) { return __uint_as_float(w << 16); }
__device__ __forceinline__ float bfhi(unsigned w) { return __uint_as_float(w & 0xffff0000u); }
__device__ __forceinline__ unsigned cvt_pk_bf16(float lo, float hi) { unsigned r; asm volatile("v_cvt_pk_bf16_f32 %0, %1, %2" : "=v"(r) : "v"(lo), "v"(hi)); return r; }
__device__ __forceinline__ bf16_t f2bf(float f) { return (bf16_t)(cvt_pk_bf16(f, 0.f) & 0xffffu); }
__device__ __forceinline__ float wave_sum(float v) { v += __shfl_xor(v, 32); v += __shfl_xor(v, 16); v += __shfl_xor(v, 8); v += __shfl_xor(v, 4); v += __shfl_xor(v, 2); v += __shfl_xor(v, 1); return v; }
__device__ __forceinline__ float sum8(float v) { v += __shfl_xor(v, 4); v += __shfl_xor(v, 2); v += __shfl_xor(v, 1); return v; }
__device__ __forceinline__ float silu(float z) { return z / (1.f + __expf(-z)); }
__device__ __forceinline__ float sigmoidf(float z) { return 1.f / (1.f + __expf(-z)); }
__device__ __forceinline__ void unpack8(u32x4 w, float* f) { f[0] = bflo(w.x); f[1] = bfhi(w.x); f[2] = bflo(w.y); f[3] = bfhi(w.y); f[4] = bflo(w.z); f[5] = bfhi(w.z); f[6] = bflo(w.w); f[7] = bfhi(w.w); }
__device__ __forceinline__ u32x4 pack8(const float* f) { u32x4 w; w.x = cvt_pk_bf16(f[0], f[1]); w.y = cvt_pk_bf16(f[2], f[3]); w.z = cvt_pk_bf16(f[4], f[5]); w.w = cvt_pk_bf16(f[6], f[7]); return w; }

namespace pg8 {
#define PG8_LAS __attribute__((address_space(3)))
constexpr int BM = 256, BK = 64, HALF = 128, HTB = HALF * BK * 2, STAGE_BYTES = 8 * HTB, NXCD = 8, WGM = 8;
__host__ __device__ __forceinline__ int lds_byte(int r, int c) { const int st = (r >> 4) * 2 + (c >> 5), rr = r & 15, cc = c & 31, ob = rr * 64 + cc * 2; return st * 1024 + (ob ^ (((ob >> 9) & 1) << 5)); }
__host__ __device__ __forceinline__ void stage_rc(int b, int& R, int& C) { const int st = b / 1024, sb = b % 1024, swz = sb ^ (((sb >> 9) & 1) << 5); R = (st >> 1) * 16 + swz / 64; C = (st & 1) * 32 + (swz % 64) / 2; }
__host__ __device__ __forceinline__ int perm32(int rho) { const int n = rho >> 4, i = rho & 15; return 8 * (i >> 2) + 4 * n + (i & 3); }
struct Unit { int pm, pn; };
struct Gemm { const bf16_t* A; const bf16_t* Bt; int M, N, K; };
struct StaticOrder {
    int nM, nN, nwg, G, c;
    __device__ void init(int M, int N, int G_, int c_) { nM = M / BM; nN = N / BM; nwg = nM * nN; G = G_; c = c_; }
    __device__ bool next(int i, Unit& u) const {
        const long L = (long)i * G + c; if (L >= nwg) return false;
        int wgid = (int)L; { const int q = nwg / NXCD, r = nwg % NXCD, xcd = wgid % NXCD, off = wgid / NXCD; wgid = (xcd < r ? xcd * (q + 1) : r * (q + 1) + (xcd - r) * q) + off; }
        const int nig = WGM * nN, gid = wgid / nig, fm = gid * WGM, gsz = (nM - fm) < WGM ? (nM - fm) : WGM;
        u.pm = fm + ((wgid % nig) % gsz); u.pn = (wgid % nig) / gsz; return true;
    }
};
template <class Epi>
__device__ __forceinline__ void gemm_phase(PG8_LAS unsigned char* lds, const Gemm g, const StaticOrder& S, const Epi& E, int wv) {
    const int tid = otid(wv), wid = __builtin_amdgcn_readfirstlane(tid >> 6), lane = tid & 63, wr = wid >> 2, wc = wid & 3, fr = lane & 15, fq = lane >> 4;
    const int K = g.K, nt = K / BK;
    unsigned voffA[2], voffB[2];
#pragma unroll
    for (int i = 0; i < 2; ++i) { int R, C; stage_rc(tid * 16 + i * 8192, R, C); const int Rb = Epi::PERM ? ((R & ~31) + perm32(R & 31)) : R;
        voffA[i] = (unsigned)(R * K + C) * 2u; voffB[i] = (unsigned)(Rb * K + C) * 2u; }
    const size_t kstep = (size_t)(BK * 2);
    const size_t hstep = (size_t)HALF * K * 2;
    const size_t tstep = 2 * hstep;
    const unsigned ldsw = (unsigned)wid * 1024u;
    const int aoff = lds_byte(wr * 64 + fr, fq * 8), boff = lds_byte(wc * 32 + fr, fq * 8);
#define PG8_SA(b, h) (((b) * 2 + (h)) * HTB)
#define PG8_SB(b, h) ((4 + (b) * 2 + (h)) * HTB)
#define PG8_STAGE(bufoff, gbase, voff) do { _Pragma("unroll") for (int _i = 0; _i < 2; ++_i) \
        __builtin_amdgcn_global_load_lds((const unsigned*)((const char*)(gbase) + (voff)[_i]), (PG8_LAS unsigned*)(lds + (bufoff) + ldsw + _i * 8192), 16, 0, 0); } while (0)
#define PG8_LDA(dst, b, h) do { _Pragma("unroll") for (int m = 0; m < 4; ++m) _Pragma("unroll") for (int k = 0; k < 2; ++k) dst[m][k] = *(const PG8_LAS bf16x8*)(lds + PG8_SA(b, h) + aoff + m * 2048 + k * 1024); } while (0)
#define PG8_LDB(dst, b, h) do { _Pragma("unroll") for (int n = 0; n < 2; ++n) _Pragma("unroll") for (int k = 0; k < 2; ++k) dst[n][k] = *(const PG8_LAS bf16x8*)(lds + PG8_SB(b, h) + boff + n * 2048 + k * 1024); } while (0)
#define PG8_MMA(ai, bj, At, Bt) do { __builtin_amdgcn_s_setprio(1); _Pragma("unroll") for (int m = 0; m < 4; ++m) _Pragma("unroll") for (int n = 0; n < 2; ++n) _Pragma("unroll") for (int k = 0; k < 2; ++k) \
        acc[ai][bj][m][n] = __builtin_amdgcn_mfma_f32_16x16x32_bf16(Bt[n][k], At[m][k], acc[ai][bj][m][n], 0, 0, 0); __builtin_amdgcn_s_setprio(0); } while (0)
#define PG8_WAIT_V(n) asm volatile("s_waitcnt vmcnt(" #n ")" ::: "memory")
#define PG8_WAIT_L(n) asm volatile("s_waitcnt lgkmcnt(" #n ")" ::: "memory")
#define PG8_BAR __builtin_amdgcn_s_barrier()
#define PG8_SCHED __builtin_amdgcn_sched_barrier(0)
    Unit cur, nxt; int ui = 0;
    if (!S.next(0, cur)) return;
    f32x4 acc[2][2][4][2];
#pragma unroll
    for (int a = 0; a < 2; ++a)
#pragma unroll
        for (int b = 0; b < 2; ++b)
#pragma unroll
            for (int m = 0; m < 4; ++m)
#pragma unroll
                for (int n = 0; n < 2; ++n) acc[a][b][m][n] = (f32x4){0.f, 0.f, 0.f, 0.f};
    bf16x8 At[4][2], B0[2][2], B1[2][2];
    float hk[8];
    const char* cA = (const char*)g.A + (size_t)cur.pm * tstep; const char* cB = (const char*)g.Bt + (size_t)cur.pn * tstep;
    PG8_STAGE(PG8_SB(0, 0), cB, voffB); PG8_STAGE(PG8_SA(0, 0), cA, voffA); PG8_STAGE(PG8_SB(0, 1), cB + hstep, voffB); PG8_STAGE(PG8_SA(0, 1), cA + hstep, voffA);
    if (wr == 1) PG8_BAR;
    PG8_WAIT_V(4); PG8_BAR;
    PG8_STAGE(PG8_SB(1, 0), cB + kstep, voffB); PG8_STAGE(PG8_SA(1, 0), cA + kstep, voffA); PG8_STAGE(PG8_SB(1, 1), cB + hstep + kstep, voffB);
    PG8_WAIT_V(6); PG8_BAR;
    for (;;) {
        const bool has_next = S.next(ui + 1, nxt);
        const char* nA = has_next ? (const char*)g.A + (size_t)nxt.pm * tstep : cA; const char* nB = has_next ? (const char*)g.Bt + (size_t)nxt.pn * tstep : cB;
        constexpr int NSEG = Epi::HOOKS ? 3 : 1;
#pragma unroll
        for (int seg = 0; seg < NSEG; ++seg) {
        int tb = 0, te = nt;
        if constexpr (Epi::HOOKS) { tb = (seg == 0) ? 0 : (seg == 1 ? Epi::T1 : Epi::T2); te = (seg == 0) ? Epi::T1 : (seg == 1 ? Epi::T2 : nt);
            if (seg == 1) { PG8_SCHED; E.hook1(acc, hk, cur, wr, lane); PG8_SCHED; } if (seg == 2) { PG8_SCHED; E.hook2(acc, hk); PG8_SCHED; } }
        for (int t = tb; t < te; t += 2) {
            const bool last = (t == nt - 2);
            const char* a1 = cA + (size_t)(t + 1) * kstep;
            const char* a2 = last ? nA : cA + (size_t)(t + 2) * kstep; const char* b2 = last ? nB : cB + (size_t)(t + 2) * kstep;
            const char* a3 = a2 + kstep; const char* b3 = b2 + kstep;
            PG8_LDB(B0, 0, 0); PG8_SCHED; PG8_LDA(At, 0, 0); PG8_STAGE(PG8_SA(1, 1), a1 + hstep, voffA);
            PG8_WAIT_L(8); PG8_BAR; PG8_WAIT_L(0); PG8_MMA(0, 0, At, B0); PG8_BAR; PG8_SCHED;
            PG8_LDB(B1, 0, 1); PG8_STAGE(PG8_SB(0, 0), b2, voffB);
            PG8_BAR; PG8_WAIT_L(0); PG8_MMA(0, 1, At, B1); PG8_BAR;
            PG8_LDA(At, 0, 1); PG8_STAGE(PG8_SA(0, 0), a2, voffA);
            PG8_BAR; PG8_WAIT_L(0); PG8_MMA(1, 0, At, B0); PG8_BAR; PG8_SCHED;
            PG8_STAGE(PG8_SB(0, 1), b2 + hstep, voffB);
            PG8_WAIT_V(6); PG8_BAR; PG8_MMA(1, 1, At, B1); PG8_BAR;
            PG8_LDB(B0, 1, 0); PG8_SCHED; PG8_LDA(At, 1, 0); PG8_STAGE(PG8_SA(0, 1), a2 + hstep, voffA);
            PG8_WAIT_L(8); PG8_BAR; PG8_WAIT_L(0); PG8_MMA(0, 0, At, B0); PG8_BAR; PG8_SCHED;
            PG8_LDB(B1, 1, 1); PG8_STAGE(PG8_SB(1, 0), b3, voffB);
            PG8_BAR; PG8_WAIT_L(0); PG8_MMA(0, 1, At, B1); PG8_BAR;
            PG8_LDA(At, 1, 1); PG8_STAGE(PG8_SA(1, 0), a3, voffA);
            PG8_BAR; PG8_WAIT_L(0); PG8_MMA(1, 0, At, B0); PG8_BAR; PG8_SCHED;
            PG8_STAGE(PG8_SB(1, 1), b3 + hstep, voffB);
            PG8_WAIT_V(6); PG8_BAR; PG8_MMA(1, 1, At, B1); PG8_BAR;
        }
        }
        E(acc, cur, wr, wc, fr, fq);
        if (!has_next) break;
#pragma unroll
        for (int a = 0; a < 2; ++a)
#pragma unroll
            for (int b = 0; b < 2; ++b)
#pragma unroll
                for (int m = 0; m < 4; ++m)
#pragma unroll
                    for (int n = 0; n < 2; ++n) acc[a][b][m][n] = (f32x4){0.f, 0.f, 0.f, 0.f};
        cur = nxt; cA = nA; cB = nB; ++ui;
    }
    PG8_WAIT_V(0);
    if (wr == 0) PG8_BAR;
    PG8_BAR;
#undef PG8_SA
#undef PG8_SB
#undef PG8_STAGE
#undef PG8_LDA
#undef PG8_LDB
#undef PG8_MMA
#undef PG8_WAIT_V
#undef PG8_WAIT_L
#undef PG8_BAR
#undef PG8_SCHED
}

struct EpiBf16Store {
    static constexpr bool PERM = true; static constexpr bool HOOKS = false;
    bf16_t* O; int ldc;
    __device__ __forceinline__ void operator()(const f32x4 (&acc)[2][2][4][2], const Unit& u, int wr, int wc, int fr, int fq) const {
        const int row0 = u.pm * BM + wr * 64 + fr, col0 = u.pn * BM + wc * 32 + 8 * fq;
#pragma unroll
        for (int ai = 0; ai < 2; ++ai)
#pragma unroll
            for (int m = 0; m < 4; ++m) { bf16_t* rowp = O + (size_t)(row0 + ai * HALF + m * 16) * ldc + col0;
#pragma unroll
                for (int bj = 0; bj < 2; ++bj) { const f32x4 v0 = acc[ai][bj][m][0], v1 = acc[ai][bj][m][1];
                    u32x4 w; w.x = cvt_pk_bf16(v0[0], v0[1]); w.y = cvt_pk_bf16(v0[2], v0[3]); w.z = cvt_pk_bf16(v1[0], v1[1]); w.w = cvt_pk_bf16(v1[2], v1[3]);
                    *(u32x4*)(rowp + bj * HALF) = w; } }
    }
};
struct EpiResF32 {
    static constexpr bool PERM = false; static constexpr bool HOOKS = false;
    const float* in; float* out;
    __device__ __forceinline__ void operator()(const f32x4 (&acc)[2][2][4][2], const Unit& u, int wr, int wc, int fr, int fq) const {
        const int row0 = u.pm * BM + wr * 64 + fr, col0 = u.pn * BM + wc * 32 + 4 * fq;
#pragma unroll
        for (int ai = 0; ai < 2; ++ai)
#pragma unroll
            for (int m = 0; m < 4; ++m) { const size_t ro = (size_t)(row0 + ai * HALF + m * 16) * D_MODEL + col0;
#pragma unroll
                for (int bj = 0; bj < 2; ++bj)
#pragma unroll
                    for (int n = 0; n < 2; ++n) { const f32x4 r = *(const f32x4*)(in + ro + bj * HALF + n * 16); *(f32x4*)(out + ro + bj * HALF + n * 16) = r + acc[ai][bj][m][n]; } }
    }
};
struct EpiGate {
    static constexpr bool PERM = false; static constexpr bool HOOKS = false;
    float* h; const bf16_t* pp; const float* ssq_in;
    __device__ __forceinline__ void operator()(const f32x4 (&acc)[2][2][4][2], const Unit& u, int wr, int wc, int fr, int fq) const {
        int lx = fr | (fq << 4); asm volatile("" : "+v"(lx));
        const int frx = lx & 15, fqx = lx >> 4;
        const int row0 = u.pm * BM + wr * 64 + frx, col0 = u.pn * BM + wc * 32 + 4 * fqx;
#pragma unroll
        for (int ai = 0; ai < 2; ++ai) {
            float rs[4];
#pragma unroll
            for (int m = 0; m < 4; ++m) { const float* sp = ssq_in + ((row0 + ai * HALF + m * 16) * 32 + fqx * 8); const f32x4 a = *(const f32x4*)sp, b = *(const f32x4*)(sp + 4);
                float t = ((a[0] + a[1]) + (a[2] + a[3])) + ((b[0] + b[1]) + (b[2] + b[3])); t += __shfl_xor(t, 16); t += __shfl_xor(t, 32); rs[m] = rsqrtf(t * (1.f / 2048.f) + EPS); }
#pragma unroll
            for (int m = 0; m < 4; ++m) { const size_t ro = (size_t)(row0 + ai * HALF + m * 16) * D_MODEL + col0; const float rr = rs[m];
#pragma unroll
                for (int bj = 0; bj < 2; ++bj)
#pragma unroll
                    for (int n = 0; n < 2; ++n) { const size_t o = ro + bj * HALF + n * 16; const f32x4 r = *(const f32x4*)(h + o); const u32x2 pw = *(const u32x2*)(pp + o);
                        const f32x4 a = acc[ai][bj][m][n] * rr; f32x4 v;
                        v[0] = r[0] + sigmoidf(a[0]) * bflo(pw.x); v[1] = r[1] + sigmoidf(a[1]) * bfhi(pw.x); v[2] = r[2] + sigmoidf(a[2]) * bflo(pw.y); v[3] = r[3] + sigmoidf(a[3]) * bfhi(pw.y);
                        *(f32x4*)(h + o) = v; } } }
    }
};
struct EpiKV {
    static constexpr bool PERM = true; static constexpr bool HOOKS = false;
    bf16_t* Kb; bf16_t* KV; const float* kn_g; PG8_LAS float* xl;
    __device__ __forceinline__ void operator()(const f32x4 (&acc)[2][2][4][2], const Unit& u, int wr, int wc, int fr, int fq) const {
        const int rl0 = wr * 64 + fr, c0 = wc * 32 + 8 * fq, h = u.pn;
#pragma unroll
        for (int ai = 0; ai < 2; ++ai)
#pragma unroll
            for (int m = 0; m < 4; ++m) { const f32x4 a = acc[ai][0][m][0], b = acc[ai][0][m][1];
                float s = (a[0] * a[0] + a[1] * a[1]) + (a[2] * a[2] + a[3] * a[3]) + (b[0] * b[0] + b[1] * b[1]) + (b[2] * b[2] + b[3] * b[3]);
                s += __shfl_xor(s, 16); s += __shfl_xor(s, 32);
                if (fq == 0) xl[(ai * HALF + rl0 + m * 16) * 4 + wc] = s; }
        asm volatile("s_waitcnt lgkmcnt(0)" ::: "memory"); __builtin_amdgcn_s_barrier(); asm volatile("" ::: "memory");
        float g[8];
        { const f32x4 g0 = *(const f32x4*)(kn_g + c0), g1 = *(const f32x4*)(kn_g + c0 + 4);
#pragma unroll
          for (int j = 0; j < 4; ++j) { g[j] = g0[j]; g[4 + j] = g1[j]; } }
#pragma unroll
        for (int ai = 0; ai < 2; ++ai)
#pragma unroll
            for (int m = 0; m < 4; ++m) { const int rl = ai * HALF + rl0 + m * 16; const f32x4 p = *(const PG8_LAS f32x4*)(xl + rl * 4);
                const float rs = rsqrtf(((p[0] + p[1]) + (p[2] + p[3])) * (1.f / 128.f) + EPS);
                const int t = u.pm * BM + rl, b = t / SEQ, sq = t - b * SEQ;
                const f32x4 k0 = acc[ai][0][m][0] * rs, k1 = acc[ai][0][m][1] * rs, v0 = acc[ai][1][m][0], v1 = acc[ai][1][m][1];
                u32x4 w; w.x = cvt_pk_bf16(k0[0] * g[0], k0[1] * g[1]); w.y = cvt_pk_bf16(k0[2] * g[2], k0[3] * g[3]); w.z = cvt_pk_bf16(k1[0] * g[4], k1[1] * g[5]); w.w = cvt_pk_bf16(k1[2] * g[6], k1[3] * g[7]);
                *(u32x4*)(Kb + ((size_t)(b * 8 + h) * SEQ + sq) * 192 + c0) = w;
                u32x4 x; x.x = cvt_pk_bf16(v0[0], v0[1]); x.y = cvt_pk_bf16(v0[2], v0[3]); x.z = cvt_pk_bf16(v1[0], v1[1]); x.w = cvt_pk_bf16(v1[2], v1[3]);
                *(u32x4*)(KV + (size_t)t * 2048 + h * 256 + 128 + c0) = x; }
    }
};
struct EpiResMid {
    static constexpr bool PERM = false; static constexpr bool HOOKS = true; static constexpr int T1 = 16, T2 = 24;
    const float* in; float* out; const float* ssqa; const float* ssqc;
    bf16_t* hb; float* ssq2;
    __device__ __forceinline__ void hook1(f32x4 (&acc)[2][2][4][2], float (&hk)[8], const Unit& u, int wr, int fr) const {
        int frx = fr; asm volatile("" : "+v"(frx));
        const int row0 = u.pm * BM + wr * 64 + (frx & 15), fq = (frx >> 4) & 3;
        typedef float f32x2 __attribute__((ext_vector_type(2)));
#pragma unroll
        for (int ai = 0; ai < 2; ++ai) {
            float cs[4], as_[4];
#pragma unroll
            for (int m = 0; m < 4; ++m) { const int row = row0 + ai * HALF + m * 16; const f32x2 c = *(const f32x2*)(ssqc + (row * 8 + fq * 2)); cs[m] = c.x + c.y; as_[m] = ssqa[row * 4 + fq]; }
#pragma unroll
            for (int m = 0; m < 4; ++m) { cs[m] += __shfl_xor(cs[m], 16); cs[m] += __shfl_xor(cs[m], 32); as_[m] += __shfl_xor(as_[m], 16); as_[m] += __shfl_xor(as_[m], 32); }
#pragma unroll
            for (int m = 0; m < 4; ++m) {
                const float rsC = rsqrtf(cs[m] * (1.f / 1024.f) + EPS); const float sA = as_[m] * (1.f / 512.f) + EPS; const float rsA = rsqrtf(sA);
                hk[ai * 4 + m] = rsA; const float f = rsC * sA * rsA;
#pragma unroll
                for (int bj = 0; bj < 2; ++bj)
#pragma unroll
                    for (int n = 0; n < 2; ++n) acc[ai][bj][m][n] = acc[ai][bj][m][n] * f; }
            __builtin_amdgcn_sched_barrier(0);
        }
    }
    __device__ __forceinline__ void hook2(f32x4 (&acc)[2][2][4][2], const float (&hk)[8]) const {
#pragma unroll
        for (int ai = 0; ai < 2; ++ai)
#pragma unroll
            for (int m = 0; m < 4; ++m)
#pragma unroll
                for (int bj = 0; bj < 2; ++bj)
#pragma unroll
                    for (int n = 0; n < 2; ++n) acc[ai][bj][m][n] = acc[ai][bj][m][n] * hk[ai * 4 + m];
    }
    __device__ __forceinline__ void operator()(const f32x4 (&acc)[2][2][4][2], const Unit& u, int wr, int wc, int fr, int fq) const {
        const int row0 = u.pm * BM + wr * 64 + fr, col0 = u.pn * BM + wc * 32 + 4 * fq;
#pragma unroll
        for (int ai = 0; ai < 2; ++ai)
#pragma unroll
            for (int m = 0; m < 4; ++m) { const int row = row0 + ai * HALF + m * 16; const size_t ro = (size_t)row * D_MODEL + col0; float ss = 0.f;
#pragma unroll
                for (int bj = 0; bj < 2; ++bj)
#pragma unroll
                    for (int n = 0; n < 2; ++n) { const size_t o = ro + bj * HALF + n * 16; const f32x4 v = *(const f32x4*)(in + o) + acc[ai][bj][m][n]; *(f32x4*)(out + o) = v;
                        u32x2 w; w.x = cvt_pk_bf16(v[0], v[1]); w.y = cvt_pk_bf16(v[2], v[3]); *(u32x2*)(hb + o) = w; ss += (v[0] * v[0] + v[1] * v[1]) + (v[2] * v[2] + v[3] * v[3]); }
                ss += __shfl_xor(ss, 16); ss += __shfl_xor(ss, 32);
                if (fq == 0) ssq2[row * 32 + u.pn * 4 + wc] = ss; }
    }
};
}


#define XB_TMO      128
#define XB_XCNT(j)  (256  + 64 * (j))
#define XB_XSUB(j)  (1280 + 64 * (j))
#define XB_XGEN(j)  (2304 + 64 * (j))
#define XB_TOP      3328
#define XB_TOPGEN   3392
#define XCD_BAR_WORDS 3456
#define XB_SPIN_CAP (1u << 22)
__device__ __forceinline__ unsigned xb_ld(unsigned* p)              { return __hip_atomic_load(p, __ATOMIC_RELAXED, __HIP_MEMORY_SCOPE_AGENT); }
__device__ __forceinline__ unsigned xb_add(unsigned* p, unsigned v) { return __hip_atomic_fetch_add(p, v, __ATOMIC_RELAXED, __HIP_MEMORY_SCOPE_AGENT); }
__device__ __forceinline__ unsigned xb_xcc_id() { return (unsigned)__builtin_amdgcn_s_getreg((3 << 11) | 20) & 0xFu; }
#define XB_SPIN(cond, bar) do { unsigned _sp = 0; while (cond) { __builtin_amdgcn_s_sleep(1); \
    if ((++_sp & 255u) == 0u) { if (xb_ld(&(bar)[XB_TMO])) break; if (_sp > XB_SPIN_CAP) { atomicAdd(&(bar)[XB_TMO], 1u); break; } } } } while (0)
struct XcdBarrier { unsigned* bar; unsigned x; volatile PG8_LAS unsigned* st; };
__device__ __forceinline__ XcdBarrier xcd_barrier_post(unsigned* bar, volatile PG8_LAS unsigned* st, int wv) {
    XcdBarrier b; b.bar = bar; b.x = xb_xcc_id(); b.st = st;
    if (otid(wv) == 0) (void)xb_add(&bar[XB_XCNT(b.x)], 1u);
    return b;
}
__device__ __forceinline__ void xcd_barrier_complete(unsigned* bar, unsigned x, unsigned& nloc, unsigned& nx) {
    const unsigned G = gridDim.x * gridDim.y * gridDim.z;
    unsigned sum, cnt, mine, sp = 0u;
    for (;;) {
        sum = 0u; cnt = 0u; mine = 0u;
#pragma unroll
        for (unsigned j = 0; j < 16; ++j) { const unsigned c = xb_ld(&bar[XB_XCNT(j)]); sum += c; cnt += (c > 0u) ? 1u : 0u; mine = (j == x) ? c : mine; }
        if (sum == G) break;
        __builtin_amdgcn_s_sleep(1);
        if ((++sp & 255u) == 0u) { if (xb_ld(&bar[XB_TMO])) break; if (sp > XB_SPIN_CAP) { atomicAdd(&bar[XB_TMO], 1u); break; } }
    }
    nloc = mine > 0u ? mine : 1u; nx = cnt > 0u ? cnt : 1u;
}
__device__ __forceinline__ void xcd_barrier(const XcdBarrier& b, int wv) {
    asm volatile("s_waitcnt vmcnt(0)" ::: "memory");
    __syncthreads();
    if (otid(wv) == 0) {
        unsigned* bar = b.bar;
        __builtin_amdgcn_s_waitcnt(0);
        unsigned nloc = b.st[0], nx = b.st[1];
        if (nloc == 0u) { xcd_barrier_complete(bar, b.x, nloc, nx); b.st[0] = nloc; b.st[1] = nx; }
        const unsigned old = xb_add(&bar[XB_XSUB(b.x)], 1u);
        const unsigned gen = old / nloc;
        if (old + 1u == (gen + 1u) * nloc) {
            __builtin_amdgcn_fence(__ATOMIC_RELEASE, "agent");
            asm volatile("s_waitcnt vmcnt(0)" ::: "memory");
            const unsigned og = xb_add(&bar[XB_TOP], 1u);
            const unsigned tg = og / nx;
            if (og + 1u == (tg + 1u) * nx) xb_add(&bar[XB_TOPGEN], 1u);
            else XB_SPIN(xb_ld(&bar[XB_TOPGEN]) == tg, bar);
            __builtin_amdgcn_fence(__ATOMIC_ACQUIRE, "agent");
            xb_add(&bar[XB_XGEN(b.x)], 1u);
            asm volatile("s_waitcnt vmcnt(0)" ::: "memory");
        } else {
            XB_SPIN(xb_ld(&bar[XB_XGEN(b.x)]) == gen, bar);
            __builtin_amdgcn_fence(__ATOMIC_ACQUIRE, "agent");
            asm volatile("s_waitcnt vmcnt(0)" ::: "memory");
        }
    }
    __syncthreads();
}

namespace att {
constexpr int QPARK_OFF = 8 * 128 * 64 * 2 + 16 + 4096;
constexpr int DQ = 192, NW = 8, QBLK = 32, KVBLK = 64;
constexpr float SCALE = 0.07216878364870322f;
constexpr float THR = 8.f;
constexpr int LDQ = 192, LDK = 192, LDV = 2048;
constexpr int SHM_V = KVBLK * 128 * 2, SHM_K = KVBLK * DQ * 2, OFF_K = 3 * SHM_V, OFF_W = OFF_K + 3 * SHM_K, SHM_ATTN = OFF_W + NW * 64 * 4, NQREG = 12, SHM_QPARK = (12 - NQREG) * 512 * 16;
#define KSWZ(row, colB) ((row) * 384 + ((colB) ^ ((((row) >> 1) & 7) << 4)))
#define SBAR() __builtin_amdgcn_sched_barrier(0)
__device__ __forceinline__ int crow(int r, int hi) { return (r & 3) + 8 * (r >> 2) + 4 * hi; }
__device__ __forceinline__ void partialSM(f32x16& p0, f32x16& p1, float& m_reg, float& mn, float& alpha) {
    constexpr float C = SCALE * 1.4426950408889634f;
    float pmax = p0[0];
#pragma unroll
    for (int r = 1; r < 16; ++r) pmax = fmaxf(pmax, p0[r]);
#pragma unroll
    for (int r = 0; r < 16; ++r) pmax = fmaxf(pmax, p1[r]);
    { auto rr = __builtin_amdgcn_permlane32_swap(__float_as_uint(pmax), __float_as_uint(pmax), false, false);
      pmax = fmaxf(__uint_as_float(rr[0]), __uint_as_float(rr[1])); }
    if (__builtin_expect(__all(pmax - m_reg <= THR / SCALE), 1)) { mn = m_reg; alpha = 1.f; }
    else { mn = fmaxf(m_reg, pmax); alpha = __builtin_amdgcn_exp2f((m_reg - mn) * C); m_reg = mn; }
    float mnC = -mn * C;
#pragma unroll
    for (int r = 0; r < 16; ++r) p0[r] = fmaf(p0[r], C, mnC);
#pragma unroll
    for (int r = 0; r < 16; ++r) p1[r] = fmaf(p1[r], C, mnC);
#pragma unroll
    for (int r = 0; r < 16; ++r) p0[r] = __builtin_amdgcn_exp2f(p0[r]);
}
__device__ __forceinline__ void finishSM(f32x16& p0, f32x16& p1, float alpha, float& l_reg, bf16x8& pa0, bf16x8& pa1, bf16x8& pa2, bf16x8& pa3) {
#pragma unroll
    for (int r = 0; r < 16; ++r) p1[r] = __builtin_amdgcn_exp2f(p1[r]);
    float ps = 0;
#pragma unroll
    for (int r = 0; r < 16; ++r) ps += p0[r];
#pragma unroll
    for (int r = 0; r < 16; ++r) ps += p1[r];
    { auto rr = __builtin_amdgcn_permlane32_swap(__float_as_uint(ps), __float_as_uint(ps), false, false);
      ps = __uint_as_float(rr[0]) + __uint_as_float(rr[1]); }
    l_reg = l_reg * alpha + ps;
#define PK4(P, BASE, OUT) do { unsigned a0 = cvt_pk_bf16(P[BASE + 0], P[BASE + 1]), a1 = cvt_pk_bf16(P[BASE + 2], P[BASE + 3]);   \
    unsigned b0 = cvt_pk_bf16(P[BASE + 4], P[BASE + 5]), b1 = cvt_pk_bf16(P[BASE + 6], P[BASE + 7]);                              \
    auto r0 = __builtin_amdgcn_permlane32_swap(a0, b0, false, false); auto r1 = __builtin_amdgcn_permlane32_swap(a1, b1, false, false); \
    u32x4 w = {r0[0], r1[0], r0[1], r1[1]}; OUT = *reinterpret_cast<bf16x8*>(&w); } while (0)
    PK4(p0, 0, pa0); PK4(p0, 8, pa1); PK4(p1, 0, pa2); PK4(p1, 8, pa3);
#undef PK4
}
__device__ __forceinline__ void qkt(f32x16& p0, f32x16& p1, const char* Ks, const bf16x8* qr, const int* ko, const char* qrl) {
    p0 = f32x16{}; p1 = f32x16{};
#pragma unroll
    for (int d0 = 0; d0 < 12; ++d0) { const char* kp = Ks + ko[d0 & 3] + (d0 >> 2) * 128;
        bf16x8 b0 = *reinterpret_cast<const bf16x8*>(kp);
        bf16x8 b1 = *reinterpret_cast<const bf16x8*>(kp + 32 * 384);
        const bf16x8 qv = (d0 < NQREG) ? qr[d0 < NQREG ? d0 : 0] : *reinterpret_cast<const bf16x8*>(qrl + (d0 - NQREG) * 8192);
        p0 = __builtin_amdgcn_mfma_f32_32x32x16_bf16(b0, qv, p0, 0, 0, 0);
        p1 = __builtin_amdgcn_mfma_f32_32x32x16_bf16(b1, qv, p1, 0, 0, 0); }
}
__device__ __forceinline__ int v_st(int k, int c) { const int kk = (k & ~0xC) | ((k & 4) << 1) | ((k & 8) >> 1); return ((kk >> 3) * 4 + (c >> 5)) * 512 + ((kk & 7) * 32 + (c & 31)) * 2; }
__device__ __forceinline__ int v_rd_base(int lane) { return ((lane & 3) << 3) | (((lane >> 2) & 3) << 6) | (((lane >> 4) & 1) << 5) | (((lane >> 5) & 1) << 8); }
constexpr int v_rd_off(int d0, int ks, int half) { return d0 * 512 + ks * 4096 + half * 2048; }
template <int OFF> __device__ __forceinline__ s16x4 tr_read(int vb) {
    s16x4 r; asm volatile("ds_read_b64_tr_b16 %0, %1 offset:%2" : "=&v"(r) : "v"(vb), "i"(OFF) : "memory"); return r;
}
struct VFrag { s16x4 l0, h0, l1, h1, l2, h2, l3, h3; };
template <int D0> __device__ __forceinline__ void v_read8(VFrag& f, int vb) {
    f.l0 = tr_read<v_rd_off(D0, 0, 0)>(vb); f.h0 = tr_read<v_rd_off(D0, 0, 1)>(vb); f.l1 = tr_read<v_rd_off(D0, 1, 0)>(vb); f.h1 = tr_read<v_rd_off(D0, 1, 1)>(vb);
    f.l2 = tr_read<v_rd_off(D0, 2, 0)>(vb); f.h2 = tr_read<v_rd_off(D0, 2, 1)>(vb); f.l3 = tr_read<v_rd_off(D0, 3, 0)>(vb); f.h3 = tr_read<v_rd_off(D0, 3, 1)>(vb);
}
__device__ __forceinline__ void pv_mma4(f32x16& od, const VFrag& f, bf16x8 pa0, bf16x8 pa1, bf16x8 pa2, bf16x8 pa3) {
#define PK(L, H) (bf16x8){L[0], L[1], L[2], L[3], H[0], H[1], H[2], H[3]}
    od = __builtin_amdgcn_mfma_f32_32x32x16_bf16(pa0, PK(f.l0, f.h0), od, 0, 0, 0);
    od = __builtin_amdgcn_mfma_f32_32x32x16_bf16(pa1, PK(f.l1, f.h1), od, 0, 0, 0);
    od = __builtin_amdgcn_mfma_f32_32x32x16_bf16(pa2, PK(f.l2, f.h2), od, 0, 0, 0);
    od = __builtin_amdgcn_mfma_f32_32x32x16_bf16(pa3, PK(f.l3, f.h3), od, 0, 0, 0);
#undef PK
}
__device__ __forceinline__ void pv_d0_1(f32x16* o, int vb, bf16x8 pa0, bf16x8 pa1, bf16x8 pa2, bf16x8 pa3) {
    VFrag f;
    v_read8<0>(f, vb); asm volatile("s_waitcnt lgkmcnt(0)" ::: "memory"); SBAR(); pv_mma4(o[0], f, pa0, pa1, pa2, pa3); SBAR();
    v_read8<1>(f, vb); asm volatile("s_waitcnt lgkmcnt(0)" ::: "memory"); SBAR(); pv_mma4(o[1], f, pa0, pa1, pa2, pa3); SBAR();
    v_read8<2>(f, vb); asm volatile("s_waitcnt lgkmcnt(0)" ::: "memory"); SBAR(); pv_mma4(o[2], f, pa0, pa1, pa2, pa3); SBAR();
    v_read8<3>(f, vb); asm volatile("s_waitcnt lgkmcnt(0)" ::: "memory"); SBAR(); pv_mma4(o[3], f, pa0, pa1, pa2, pa3);
}
__device__ __forceinline__ void pv_d0(f32x16* o, int vb, bf16x8 pa0, bf16x8 pa1, bf16x8 pa2, bf16x8 pa3) {
    VFrag fa, fb;
    v_read8<0>(fa, vb); v_read8<1>(fb, vb);
    asm volatile("s_waitcnt lgkmcnt(8)" ::: "memory"); SBAR(); pv_mma4(o[0], fa, pa0, pa1, pa2, pa3); SBAR();
    v_read8<2>(fa, vb);
    asm volatile("s_waitcnt lgkmcnt(8)" ::: "memory"); SBAR(); pv_mma4(o[1], fb, pa0, pa1, pa2, pa3); SBAR();
    v_read8<3>(fb, vb);
    asm volatile("s_waitcnt lgkmcnt(8)" ::: "memory"); SBAR(); pv_mma4(o[2], fa, pa0, pa1, pa2, pa3); SBAR();
    asm volatile("s_waitcnt lgkmcnt(0)" ::: "memory"); SBAR(); pv_mma4(o[3], fb, pa0, pa1, pa2, pa3);
}
__device__ __forceinline__ void attn_body(const bf16_t* __restrict__ Qb, const bf16_t* __restrict__ Kh, const bf16_t* __restrict__ Vh,
                                          const bf16_t* __restrict__ Zb, bf16_t* __restrict__ Yb, float* __restrict__ Sq, int seq, char* lds, int wv) {
    const int tid = otid(wv), wid = __builtin_amdgcn_readfirstlane(tid >> 6), lane = tid & 63, r32 = lane & 31, hi = lane >> 5;
    PG8_LAS char* l3 = (PG8_LAS char*)lds;
    char* V_lds = lds; char* K_lds = lds + OFF_K;
    float* wsl = (float*)(lds + OFF_W) + wid * 64; float* li_l = wsl; float* al_l = wsl + 32;
    float m_reg = -1e30f, l_reg = 0; f32x16 o[4] = {}; bf16x8 qr[NQREG];
    char* qrl = lds + QPARK_OFF + tid * 16;
    const bf16_t* Qw = Qb + (long)(wid * QBLK + r32) * LDQ + hi * 8;
#pragma unroll
    for (int d0 = 0; d0 < NQREG; ++d0) qr[d0] = *reinterpret_cast<const bf16x8*>(Qw + d0 * 16);
#pragma unroll
    for (int d0 = NQREG; d0 < 12; ++d0) *reinterpret_cast<bf16x8*>(qrl + (d0 - NQREG) * 8192) = *reinterpret_cast<const bf16x8*>(Qw + d0 * 16);
    int kg[3], vg[2];
#pragma unroll
    for (int i = 0; i < 3; ++i) { const int p = (wid * 3 + i) * 64 + lane, row = p / 24, cp = p % 24, c = cp ^ ((row >> 1) & 7); kg[i] = row * LDK + c * 8; }
#pragma unroll
    for (int i = 0; i < 2; ++i) { const int sl = (wid * 2 + i) * 64 + lane, kk = ((sl >> 7) << 3) | ((sl >> 2) & 7), c = ((sl >> 5) & 3) * 32 + (sl & 3) * 8;
        const int k = (kk & ~0xC) | ((kk & 4) << 1) | ((kk & 8) >> 1); vg[i] = k * LDV + c; }
    const int vb0 = (int)(uintptr_t)V_lds + v_rd_base(lane);
    int ko[4];
#pragma unroll
    for (int e = 0; e < 4; ++e) ko[e] = r32 * 384 + (((e * 2 + hi) ^ ((r32 >> 1) & 7)) << 4);
#define KISSUE(tile, buf) do { const bf16_t* Kt_ = Kh + (size_t)(tile) * (KVBLK * LDK); _Pragma("unroll") for (int i_ = 0; i_ < 3; ++i_) \
    __builtin_amdgcn_global_load_lds((const unsigned*)(Kt_ + kg[i_]), (PG8_LAS unsigned*)(l3 + OFF_K + (buf) * SHM_K + (wid * 3 + i_) * 1024), 16, 0, 0); } while (0)
#define VISSUE(tile, buf) do { const bf16_t* Vt_ = Vh + (size_t)(tile) * (KVBLK * LDV); _Pragma("unroll") for (int i_ = 0; i_ < 2; ++i_) \
    __builtin_amdgcn_global_load_lds((const unsigned*)(Vt_ + vg[i_]), (PG8_LAS unsigned*)(l3 + (buf) * SHM_V + (wid * 2 + i_) * 1024), 16, 0, 0); } while (0)
#define WAITV(n) asm volatile("s_waitcnt vmcnt(" #n ")" ::: "memory")
#define WBAR() do { __builtin_amdgcn_s_barrier(); asm volatile("" ::: "memory"); } while (0)
#define NEXT3(x) ((x) == 2 ? 0 : (x) + 1)
#define RESC(a) do { if (__any((a) < 1.f)) { if (hi == 0) al_l[r32] = (a); asm volatile("s_waitcnt lgkmcnt(0)" ::: "memory"); \
    _Pragma("unroll") for (int d = 0; d < 4; ++d) _Pragma("unroll") for (int r = 0; r < 16; ++r) o[d][r] *= al_l[crow(r, hi)]; } } while (0)
    f32x16 pA0, pA1, pB0, pB1; float mnA, mnB, alA, alB; bf16x8 pa0, pa1, pa2, pa3; const int NT = seq / KVBLK;
    WAITV(0);
    KISSUE(0, 0);
    KISSUE(1, 1); VISSUE(0, 0);
    WAITV(5); WBAR();
    KISSUE(2, 2); VISSUE(1, 1);
    qkt(pA0, pA1, K_lds, qr, ko, qrl); partialSM(pA0, pA1, m_reg, mnA, alA);
    int kb = 1, vbi = 0;
    const int half = wid >> 2;
#define STEP_A(PC0, PC1, MNC, ALC, PP0, PP1, ALP) do { \
        SBAR(); qkt(PC0, PC1, K_lds + kb * SHM_K, qr, ko, qrl); \
        finishSM(PP0, PP1, ALP, l_reg, pa0, pa1, pa2, pa3); SBAR(); \
        pv_d0(o, vb0 + vbi * SHM_V, pa0, pa1, pa2, pa3); partialSM(PC0, PC1, m_reg, MNC, ALC); \
        RESC(ALC); kb = NEXT3(kb); vbi = NEXT3(vbi); } while (0)
#define STEP_B(PC0, PC1, MNC, ALC, PP0, PP1, ALP) do { \
        SBAR(); finishSM(PP0, PP1, ALP, l_reg, pa0, pa1, pa2, pa3); SBAR(); \
        qkt(PC0, PC1, K_lds + kb * SHM_K, qr, ko, qrl); SBAR(); \
        partialSM(PC0, PC1, m_reg, MNC, ALC); SBAR(); \
        pv_d0_1(o, vb0 + vbi * SHM_V, pa0, pa1, pa2, pa3); \
        RESC(ALC); kb = NEXT3(kb); vbi = NEXT3(vbi); } while (0)
#define MAINLOOP(STEP) for (int j = 1; j + 1 < NT; j += 2) { \
        WAITV(5); WBAR(); \
        { const int k2 = NEXT3(NEXT3(kb)), v1 = NEXT3(NEXT3(vbi)); KISSUE(j + 2, k2); VISSUE(j + 1, v1); } \
        STEP(pB0, pB1, mnB, alB, pA0, pA1, alA); \
        WAITV(5); WBAR(); \
        { const int k2 = NEXT3(NEXT3(kb)), v1 = NEXT3(NEXT3(vbi)); if (j + 3 < NT) KISSUE(j + 3, k2); VISSUE(j + 2, v1); } \
        STEP(pA0, pA1, mnA, alA, pB0, pB1, alB); }
    (void)half; MAINLOOP(STEP_A)
    WAITV(0); WBAR();
    SBAR(); qkt(pB0, pB1, K_lds + kb * SHM_K, qr, ko, qrl);
    finishSM(pA0, pA1, alA, l_reg, pa0, pa1, pa2, pa3); SBAR();
    pv_d0(o, vb0 + vbi * SHM_V, pa0, pa1, pa2, pa3); partialSM(pB0, pB1, m_reg, mnB, alB);
    RESC(alB);
    vbi = NEXT3(vbi);
    finishSM(pB0, pB1, alB, l_reg, pa0, pa1, pa2, pa3); SBAR();
    pv_d0(o, vb0 + vbi * SHM_V, pa0, pa1, pa2, pa3);
    if (hi == 0) li_l[r32] = l_reg; asm volatile("s_waitcnt lgkmcnt(0)" ::: "memory");
    int er = wid * QBLK + 4 * hi; asm volatile("" : "+v"(er));
#pragma unroll
    for (int r = 0; r < 16; ++r) { const int ro = er + (r & 3) + 8 * (r >> 2); const float rli = __builtin_amdgcn_rcpf(li_l[ro - wid * QBLK]);
        const bf16_t* zp = Zb + ro * LDP + r32; bf16_t* yp = Yb + ro * 2048 + r32; float sq = 0.f;
#pragma unroll
        for (int d0 = 0; d0 < 4; ++d0) { const float z = bf2f(zp[d0 * 32]); const float y = o[d0][r] * rli * silu(z); sq += y * y; yp[d0 * 32] = f2bf(y); }
        sq += __shfl_xor(sq, 1); sq += __shfl_xor(sq, 2); sq += __shfl_xor(sq, 4); sq += __shfl_xor(sq, 8); sq += __shfl_xor(sq, 16);
        if (r32 == 0) Sq[ro * 8] = sq; }
    __syncthreads();
#undef STEP_A
#undef STEP_B
#undef MAINLOOP
#undef KISSUE
#undef VISSUE
#undef WAITV
#undef WBAR
#undef NEXT3
#undef RESC
}
}

struct TrJob { const float* W; const float* gain; bf16_t* Wt; int K, N, Npad, krot; };
__device__ __forceinline__ void tr_load(const TrJob& J, int tile, int tid, f32x4 (&v)[8]) {
    const int ntn = J.Npad / 128, tk = tile / ntn, tn = tile % ntn, k0 = tk * 128, n0 = tn * 128, c4 = (tid & 31) * 4, r0 = tid >> 5;
#pragma unroll
    for (int i = 0; i < 8; ++i) { const int k = k0 + r0 + i * 16; f32x4 x = (f32x4){0.f, 0.f, 0.f, 0.f};
        if (n0 + c4 < J.N) { x = *(const f32x4*)(J.W + (size_t)k * J.N + n0 + c4); if (J.gain) { const float g = J.gain[k]; x = x * g; } }
        v[i] = x; }
}
constexpr int TR_IN = (2048 / 128) * (LDP / 128), TR_UKV = (512 / 128) * (2048 / 128), TR_SQ = (2048 / 128) * (2048 / 128), TR_PP = (256 / 128) * (2048 / 128);
constexpr int TR_E0 = DEPTH * TR_IN, TR_E1 = TR_E0 + DEPTH * TR_UKV, TR_E2 = TR_E1 + DEPTH * TR_SQ, TR_E3 = TR_E2 + DEPTH * TR_SQ, TR_E4 = TR_E3 + DEPTH * TR_PP;
__device__ __forceinline__ TrJob tr_decode(KPtr P, int g, int& tile) {
    unsigned char* ws = P->ws; TrJob J;
    if (g < TR_E0) { const int l = g / TR_IN; tile = g - l * TR_IN; J = TrJob{P->w_in + (size_t)l * 2048 * IN_W, P->attn_norm + l * 2048, (bf16_t*)(ws + WS_WT_IN) + (size_t)l * LDP * 2048, 2048, IN_W, LDP, 0}; }
    else if (g < TR_E1) { const int q = g - TR_E0, l = q / TR_UKV; tile = q - l * TR_UKV; J = TrJob{P->w_ukv + (size_t)l * 512 * 2048, P->kv_norm + l * 512, (bf16_t*)(ws + WS_WT_UKV) + (size_t)l * 2048 * 512, 512, 2048, 2048, 0}; }
    else if (g < TR_E2) { const int q = g - TR_E1, l = q / TR_SQ; tile = q - l * TR_SQ; J = TrJob{P->w_out + (size_t)l * 2048 * 2048, P->out_norm + l * 2048, (bf16_t*)(ws + WS_WT_OUT) + (size_t)l * 2048 * 2048, 2048, 2048, 2048, 1024}; }
    else if (g < TR_E3) { const int q = g - TR_E2, l = q / TR_SQ; tile = q - l * TR_SQ; J = TrJob{P->w_ple_gate + (size_t)l * 2048 * 2048, P->ple_norm + l * 2048, (bf16_t*)(ws + WS_WT_G) + (size_t)l * 2048 * 2048, 2048, 2048, 2048, 0}; }
    else { const int q = g - TR_E3, l = q / TR_PP; tile = q - l * TR_PP; J = TrJob{P->w_ple_proj + (size_t)l * 256 * 2048, nullptr, (bf16_t*)(ws + WS_WT_PP) + (size_t)l * 2048 * 256, 256, 2048, 2048, 0}; }
    return J;
}
__device__ __forceinline__ void transpose_flat(KPtr P, float* lds, int wv) {
    const int tid = otid(wv);
    int g = blockIdx.x; if (g >= TR_E4) return;
    int tile; TrJob J = tr_decode(P, g, tile);
    f32x4 v[8]; tr_load(J, tile, tid, v);
    for (;;) {
        const int c4 = (tid & 31) * 4, r0 = tid >> 5;
#pragma unroll
        for (int i = 0; i < 8; ++i) { float* d = lds + (r0 + i * 16) * 129 + c4; d[0] = v[i][0]; d[1] = v[i][1]; d[2] = v[i][2]; d[3] = v[i][3]; }
        __syncthreads();
        const TrJob Jc = J; const int cur = tile; g += gridDim.x; const bool more = g < TR_E4;
        if (more) { J = tr_decode(P, g, tile); tr_load(J, tile, tid, v); }
        const int ntn = Jc.Npad / 128, tk = cur / ntn, tn = cur % ntn, k0 = tk * 128, n0 = tn * 128;
#pragma unroll
        for (int j = 0; j < 4; ++j) { const int c = tid + j * 512, kc = c & 15, n = c >> 4; const float* sp = lds + (kc * 8) * 129 + n;
            u32x4 w; w.x = cvt_pk_bf16(sp[0], sp[129]); w.y = cvt_pk_bf16(sp[2 * 129], sp[3 * 129]); w.z = cvt_pk_bf16(sp[4 * 129], sp[5 * 129]); w.w = cvt_pk_bf16(sp[6 * 129], sp[7 * 129]);
            *(u32x4*)(Jc.Wt + (size_t)(n0 + n) * Jc.K + ((k0 + Jc.krot) % Jc.K) + kc * 8) = w; }
        __syncthreads();
        if (!more) break;
    }
}
__device__ void phase_prep(KPtr P, float* lds, int wv) {
    unsigned char* ws = P->ws;
    transpose_flat(P, lds, wv);
    { const size_t n4 = (size_t)DEPTH * T * PLE / 4; const f32x4* src = (const f32x4*)P->p; u32x2* dst = (u32x2*)(ws + WS_PB);
      for (size_t i = (size_t)blockIdx.x * NTHR + otid(wv); i < n4; i += (size_t)gridDim.x * NTHR) { const f32x4 v = src[i]; u32x2 w; w.x = cvt_pk_bf16(v[0], v[1]); w.y = cvt_pk_bf16(v[2], v[3]); dst[i] = w; } }
    { float* cs = (float*)(ws + WS_COS); float* sn = (float*)(ws + WS_SIN);
      for (int i = blockIdx.x * NTHR + otid(wv); i < T * 32; i += gridDim.x * NTHR) { const int t = i >> 5, f = i & 31;
          const double inv = exp(-(double)(2 * f) / 64.0 * 9.210340371976184); const double ang = (double)P->positions[t] * inv; cs[i] = (float)cos(ang); sn[i] = (float)sin(ang); } }
}
__device__ void phase_rownorm(const float* __restrict__ src, bf16_t* __restrict__ dst, int wv) {
    const int tid = otid(wv), wid = tid >> 6, lane = tid & 63, stride = gridDim.x * 8;
    int row = blockIdx.x * 8 + wid; f32x4 v[8], nv[8];
    if (row < T) { const f32x4* p = (const f32x4*)(src + (size_t)row * 2048);
#pragma unroll
        for (int j = 0; j < 8; ++j) v[j] = p[lane + 64 * j]; }
    for (; row < T; row += stride) {
        const int rn = row + stride; const bool more = rn < T;
        if (more) { const f32x4* p = (const f32x4*)(src + (size_t)rn * 2048);
#pragma unroll
            for (int j = 0; j < 8; ++j) nv[j] = p[lane + 64 * j]; }
        float ss = 0.f;
#pragma unroll
        for (int j = 0; j < 8; ++j) ss += v[j][0] * v[j][0] + v[j][1] * v[j][1] + v[j][2] * v[j][2] + v[j][3] * v[j][3];
        ss = wave_sum(ss); const float rs = rsqrtf(ss * (1.f / 2048.f) + EPS);
        u32x2* d = (u32x2*)(dst + (size_t)row * 2048);
#pragma unroll
        for (int j = 0; j < 8; ++j) { u32x2 w; w.x = cvt_pk_bf16(v[j][0] * rs, v[j][1] * rs); w.y = cvt_pk_bf16(v[j][2] * rs, v[j][3] * rs); d[lane + 64 * j] = w; }
        if (more) {
#pragma unroll
            for (int j = 0; j < 8; ++j) v[j] = nv[j]; }
    }
}
__device__ void phase_post_rows(KPtr P, int l, int wv) {
    unsigned char* ws = P->ws; const bf16_t* __restrict__ PROJ = (const bf16_t*)(ws + WS_PROJ); bf16_t* __restrict__ Q = (bf16_t*)(ws + WS_Q); bf16_t* __restrict__ Kb = (bf16_t*)(ws + WS_K);
    bf16_t* __restrict__ CK = (bf16_t*)(ws + WS_CKVN); bf16_t* __restrict__ Y = (bf16_t*)(ws + WS_Y); const float* __restrict__ COS = (const float*)(ws + WS_COS); const float* __restrict__ SIN = (const float*)(ws + WS_SIN);
    const int tid = otid(wv), wid = tid >> 6, lane = tid & 63, h = lane >> 3, sub = lane & 7, ch = lane * 8, fi = (sub & 3) * 8;
    float gqn[16], gqr[8], gkr[8], w0[8], w1[8], w2[8], cb[8];
    { const float* qn_g = P->q_nope_norm + l * 128 + sub * 16; const float* qr_g = P->q_rope_norm + l * 64 + sub * 8; const float* kr_g = P->k_rope_norm + l * 64 + sub * 8;
      const float* cw = P->conv_w + (size_t)l * 3 * 512 + ch; const float* cbias = P->conv_b + (size_t)l * 512 + ch;
#pragma unroll
      for (int e = 0; e < 16; ++e) gqn[e] = qn_g[e];
#pragma unroll
      for (int e = 0; e < 8; ++e) { gqr[e] = qr_g[e]; gkr[e] = kr_g[e]; w0[e] = cw[e]; w1[e] = cw[512 + e]; w2[e] = cw[1024 + e]; cb[e] = cbias[e]; } }
    for (int t = blockIdx.x * 8 + wid; t < T; t += gridDim.x * 8) {
        const int b = t / SEQ, s = t % SEQ; const bf16_t* pr = PROJ + (size_t)t * LDP;
        const size_t qo = ((size_t)(b * 8 + h) * SEQ + s) * 192;
        const bool hasm = s > 0, hasp = s < SEQ - 1; const u32x4 zero4 = {0u, 0u, 0u, 0u};
        const u32x4 lqn0 = *(const u32x4*)(pr + OFF_CQ + 192 * h + sub * 16), lqn1 = *(const u32x4*)(pr + OFF_CQ + 192 * h + sub * 16 + 8);
        const u32x4 lqr = *(const u32x4*)(pr + OFF_CQ + 192 * h + 128 + sub * 8), lkr = *(const u32x4*)(pr + OFF_CKR + sub * 8), lkv = *(const u32x4*)(pr + OFF_CKV + ch);
        const u32x4 lbb = *(const u32x4*)(pr + OFF_BB + ch), lc0 = *(const u32x4*)(pr + OFF_BC + ch), lh0 = *(const u32x4*)(pr + OFF_BH + ch), lzz = *(const u32x4*)(pr + OFF_BZ + ch);
        const u32x4 lcm = hasm ? *(const u32x4*)(pr - LDP + OFF_BC + ch) : zero4, lhm = hasm ? *(const u32x4*)(pr - LDP + OFF_BH + ch) : zero4;
        const u32x4 lcp = hasp ? *(const u32x4*)(pr + LDP + OFF_BC + ch) : zero4, lhp = hasp ? *(const u32x4*)(pr + LDP + OFF_BH + ch) : zero4;
        const f32x4 lc0s = *(const f32x4*)(COS + (size_t)t * 32 + fi), lc1s = *(const f32x4*)(COS + (size_t)t * 32 + fi + 4), ls0s = *(const f32x4*)(SIN + (size_t)t * 32 + fi), ls1s = *(const f32x4*)(SIN + (size_t)t * 32 + fi + 4);
        float cs[8], sn[8];
#pragma unroll
        for (int e = 0; e < 4; ++e) { cs[e] = lc0s[e]; cs[4 + e] = lc1s[e]; sn[e] = ls0s[e]; sn[4 + e] = ls1s[e]; }
        {
            float f[16]; unpack8(lqn0, f); unpack8(lqn1, f + 8);
            float ss = 0.f;
#pragma unroll
            for (int e = 0; e < 16; ++e) ss += f[e] * f[e];
            ss = sum8(ss); const float rs = rsqrtf(ss * (1.f / 128.f) + EPS);
#pragma unroll
            for (int e = 0; e < 16; ++e) f[e] = f[e] * rs * gqn[e];
            u32x4* d = (u32x4*)(Q + qo + sub * 16); d[0] = pack8(f); d[1] = pack8(f + 8);
        }
        {
            float f[8]; unpack8(lqr, f);
            float ss = 0.f;
#pragma unroll
            for (int e = 0; e < 8; ++e) ss += f[e] * f[e];
            ss = sum8(ss); const float rs = rsqrtf(ss * (1.f / 64.f) + EPS); float o8[8];
#pragma unroll
            for (int e = 0; e < 8; ++e) { const float xn = f[e] * rs * gqr[e]; const float pt = __shfl_xor(xn, 4);
                o8[e] = (sub < 4) ? (xn * cs[e] - pt * sn[e]) : (xn * cs[e] + pt * sn[e]); }
            *(u32x4*)(Q + qo + 128 + sub * 8) = pack8(o8);
        }
        {
            float f[8]; unpack8(lkr, f);
            float ss = 0.f;
#pragma unroll
            for (int e = 0; e < 8; ++e) ss += f[e] * f[e];
            ss = sum8(ss); const float rs = rsqrtf(ss * (1.f / 64.f) + EPS); float o8[8];
#pragma unroll
            for (int e = 0; e < 8; ++e) { const float xn = f[e] * rs * gkr[e]; const float pt = __shfl_xor(xn, 4);
                o8[e] = (sub < 4) ? (xn * cs[e] - pt * sn[e]) : (xn * cs[e] + pt * sn[e]); }
            *(u32x4*)(Kb + qo + 128 + sub * 8) = pack8(o8);
        }
        {
            float f[8]; unpack8(lkv, f);
            float ss = 0.f;
#pragma unroll
            for (int e = 0; e < 8; ++e) ss += f[e] * f[e];
            ss = wave_sum(ss); const float rs = rsqrtf(ss * (1.f / 512.f) + EPS);
#pragma unroll
            for (int e = 0; e < 8; ++e) f[e] *= rs;
            *(u32x4*)(CK + (size_t)t * 512 + ch) = pack8(f);
        }
        {
            float bb[8], c0[8], h0[8], zz[8], cm[8], hm[8], cp[8], hp[8];
            unpack8(lbb, bb); unpack8(lc0, c0); unpack8(lh0, h0); unpack8(lzz, zz); unpack8(lcm, cm); unpack8(lhm, hm); unpack8(lcp, cp); unpack8(lhp, hp);
            float o8[8]; float ssb = 0.f;
#pragma unroll
            for (int e = 0; e < 8; ++e) { const float y = cb[e] + w0[e] * (cm[e] * hm[e]) + w1[e] * (c0[e] * h0[e]) + w2[e] * (cp[e] * hp[e]);
                o8[e] = bb[e] * y * silu(zz[e]); ssb += o8[e] * o8[e]; }
            ssb = wave_sum(ssb); const float rsb = rsqrtf(ssb * (1.f / 512.f) + EPS);
#pragma unroll
            for (int e = 0; e < 8; ++e) o8[e] *= rsb;
            *(u32x4*)(Y + (size_t)t * 2048 + YB + ch) = pack8(o8);
        }
    }
}
__device__ void phase_sgu(KPtr P, int l, char* lds, int wv) {
    unsigned char* ws = P->ws; const bf16_t* __restrict__ PROJ = (const bf16_t*)(ws + WS_PROJ); bf16_t* __restrict__ Y = (bf16_t*)(ws + WS_Y);
    const int tid = otid(wv), wid = tid >> 6, lane = tid & 63, fr = lane & 15, fq = lane >> 4;
    constexpr int VST = 264;
    for (int unit = blockIdx.x; unit < (T / 128) * 4; unit += gridDim.x) {
        const int k = unit >> 2, h = unit & 3, t0 = k * 128, n0 = wid * 16, t = t0 + n0 + fr;
        bf16_t r0[16], r1[16];
#pragma unroll
        for (int i = 0; i < 16; ++i) { const bf16_t* pv = PROJ + (size_t)(t0 + wid * 16 + i) * LDP + OFF_AV + h * 128; r0[i] = pv[lane]; r1[i] = pv[lane + 64]; }
        const float* sg = P->sgu_norm + (size_t)(l * 4 + h) * 128; const float g0 = sg[lane], g1 = sg[lane + 64];
        const float* wsp = P->w_spatial + ((size_t)(l * 4 + h) * 128 + n0 + fr) * 128 + fq * 8;
        f32x4 wa[4], wc[4];
#pragma unroll
        for (int kk = 0; kk < 4; ++kk) { wa[kk] = *(const f32x4*)(wsp + kk * 32); wc[kk] = *(const f32x4*)(wsp + kk * 32 + 4); }
        const float bias = P->b_spatial[(size_t)(l * 4 + h) * 128 + n0 + fr]; const bf16_t* pr = PROJ + (size_t)t * LDP + h * 128 + fq * 4;
        u32x2 uw[8], zw[8];
#pragma unroll
        for (int ct = 0; ct < 8; ++ct) { uw[ct] = *(const u32x2*)(pr + OFF_AU + ct * 16); zw[ct] = *(const u32x2*)(pr + OFF_AZ + ct * 16); }
#pragma unroll
        for (int i = 0; i < 16; ++i) { const int m = wid * 16 + i;
            const float x0 = bf2f(r0[i]), x1 = bf2f(r1[i]); const float ss = wave_sum(x0 * x0 + x1 * x1); const float rs = rsqrtf(ss * (1.f / 128.f) + EPS);
            *(bf16_t*)(lds + lane * VST + m * 2) = f2bf(x0 * rs * g0); *(bf16_t*)(lds + (lane + 64) * VST + m * 2) = f2bf(x1 * rs * g1); }
        __syncthreads();
        bf16x8 bw[4];
#pragma unroll
        for (int kk = 0; kk < 4; ++kk) { const f32x4 a = wa[kk], c = wc[kk];
            u32x4 w; w.x = cvt_pk_bf16(a[0], a[1]); w.y = cvt_pk_bf16(a[2], a[3]); w.z = cvt_pk_bf16(c[0], c[1]); w.w = cvt_pk_bf16(c[2], c[3]); bw[kk] = *reinterpret_cast<bf16x8*>(&w); }
        f32x4 acc[8];
#pragma unroll
        for (int ct = 0; ct < 8; ++ct) { acc[ct] = (f32x4){0.f, 0.f, 0.f, 0.f};
#pragma unroll
            for (int kk = 0; kk < 4; ++kk) { const char* ap = lds + (ct * 16 + fr) * VST + (kk * 32 + fq * 8) * 2;
                const u32x2 lo = *(const u32x2*)ap, hi2 = *(const u32x2*)(ap + 8); u32x4 w = {lo.x, lo.y, hi2.x, hi2.y};
                acc[ct] = __builtin_amdgcn_mfma_f32_16x16x32_bf16(*reinterpret_cast<bf16x8*>(&w), bw[kk], acc[ct], 0, 0, 0); } }
        float ssa = 0.f;
#pragma unroll
        for (int ct = 0; ct < 8; ++ct) {
            const float v0 = bflo(uw[ct].x) * (acc[ct][0] + bias) * silu(bflo(zw[ct].x)), v1 = bfhi(uw[ct].x) * (acc[ct][1] + bias) * silu(bfhi(zw[ct].x));
            const float v2 = bflo(uw[ct].y) * (acc[ct][2] + bias) * silu(bflo(zw[ct].y)), v3 = bfhi(uw[ct].y) * (acc[ct][3] + bias) * silu(bfhi(zw[ct].y));
            ssa += (v0 * v0 + v1 * v1) + (v2 * v2 + v3 * v3);
            u32x2 w; w.x = cvt_pk_bf16(v0, v1); w.y = cvt_pk_bf16(v2, v3); *(u32x2*)(Y + (size_t)t * 2048 + YA + h * 128 + ct * 16 + fq * 4) = w; }
        ssa += __shfl_xor(ssa, 16); ssa += __shfl_xor(ssa, 32);
        if (fq == 0) ((float*)(ws + WS_SSQA))[(size_t)t * 4 + h] = ssa;
        __syncthreads();
    }
}
__device__ void phase_attn(KPtr P, char* lds, int wv) {
    unsigned char* ws = P->ws; const bf16_t* Q = (const bf16_t*)(ws + WS_Q); const bf16_t* Kb = (const bf16_t*)(ws + WS_K); const bf16_t* KV = (const bf16_t*)(ws + WS_KV);
    const bf16_t* PROJ = (const bf16_t*)(ws + WS_PROJ); bf16_t* Y = (bf16_t*)(ws + WS_Y);
    for (int v = blockIdx.x; v < BATCH * 8 * (SEQ / 256); v += gridDim.x) {
        const int h = v & 7, qb = (v >> 3) & 31, b = v >> 8; const size_t tq = (size_t)b * SEQ + qb * 256;
        att::attn_body(Q + ((size_t)(b * 8 + h) * SEQ + qb * 256) * 192, Kb + (size_t)(b * 8 + h) * SEQ * 192, KV + (size_t)b * SEQ * 2048 + h * 256 + 128,
                       PROJ + tq * LDP + OFF_CZ + h * 128, Y + tq * 2048 + YC + h * 128, (float*)(ws + WS_SSQC) + tq * 8 + h, SEQ, lds, wv);
    }
}

constexpr int LDS_BYTES = pg8::STAGE_BYTES + 16 + 4096 + att::SHM_QPARK;
static_assert(att::QPARK_OFF == pg8::STAGE_BYTES + 16 + 4096 && LDS_BYTES <= 160 * 1024, "LDS map");
static_assert(att::SHM_ATTN <= pg8::STAGE_BYTES, "attention LDS");
__global__ void __launch_bounds__(NTHR, 2) fwd_megakernel(Params P_args) {
    extern __shared__ __attribute__((aligned(16))) unsigned char lds[];
    cg::grid_group grid = cg::this_grid();
    unsigned char* ws = kp_fresh()->ws; const int G = gridDim.x;
    bf16_t* HN = (bf16_t*)(ws + WS_Y); bf16_t* Y = (bf16_t*)(ws + WS_Y); bf16_t* PROJ = (bf16_t*)(ws + WS_PROJ); bf16_t* PPb = (bf16_t*)(ws + WS_PP);
    bf16_t* CK = (bf16_t*)(ws + WS_CKVN); bf16_t* KV = (bf16_t*)(ws + WS_KV); bf16_t* Kb = (bf16_t*)(ws + WS_K);
    PG8_LAS unsigned char* llds = (PG8_LAS unsigned char*)lds;
    volatile PG8_LAS unsigned* bst = (volatile PG8_LAS unsigned*)(llds + pg8::STAGE_BYTES);
    const int wv = __builtin_amdgcn_readfirstlane((int)threadIdx.x >> 6);
    { const int t0_ = otid(wv); if (t0_ < 4) bst[t0_] = 0u; }
    __syncthreads();
    XcdBarrier xb = xcd_barrier_post((unsigned*)(ws + WS_BAR), bst, wv);
#define GSYNC() xcd_barrier(xb, wv)

    phase_prep(kp_fresh(), (float*)lds, wv);
    grid.sync();
    for (int l = 0; l < DEPTH; ++l) {
        const float* hin = (l == 0) ? kp_fresh()->x : kp_fresh()->out;
        phase_rownorm(hin, HN, wv);
        GSYNC();
        { pg8::Gemm g{HN, (const bf16_t*)(ws + WS_WT_IN) + (size_t)l * LDP * 2048, T, LDP, 2048}; pg8::StaticOrder S; S.init(T, LDP, G, (int)blockIdx.x);
          pg8::EpiBf16Store E{PROJ, LDP}; pg8::gemm_phase(llds, g, S, E, wv); }
        GSYNC();
        phase_sgu(kp_fresh(), l, (char*)lds, wv);
        phase_post_rows(kp_fresh(), l, wv);
        GSYNC();
        { pg8::Gemm g{CK, (const bf16_t*)(ws + WS_WT_UKV) + (size_t)l * 2048 * 512, T, 2048, 512}; pg8::StaticOrder S; S.init(T, 2048, G, (int)blockIdx.x);
          pg8::EpiKV E{Kb, KV, kp_fresh()->k_nope_norm + l * 128, (PG8_LAS float*)(llds + pg8::STAGE_BYTES + 16)}; pg8::gemm_phase(llds, g, S, E, wv); }
        { pg8::Gemm g{(const bf16_t*)(ws + WS_PB) + (size_t)l * T * 256, (const bf16_t*)(ws + WS_WT_PP) + (size_t)l * 2048 * 256, T, 2048, 256}; pg8::StaticOrder S; S.init(T, 2048, G, (int)blockIdx.x);
          pg8::EpiBf16Store E{PPb, 2048}; pg8::gemm_phase(llds, g, S, E, wv); }
        GSYNC();
        phase_attn(kp_fresh(), (char*)lds, wv);
        GSYNC();
        { pg8::Gemm g{Y, (const bf16_t*)(ws + WS_WT_OUT) + (size_t)l * 2048 * 2048, T, 2048, 2048}; pg8::StaticOrder S; S.init(T, 2048, G, (int)blockIdx.x);
          pg8::EpiResMid E{hin, kp_fresh()->out, (const float*)(ws + WS_SSQA), (const float*)(ws + WS_SSQC), (bf16_t*)(ws + WS_KV), (float*)(ws + WS_SSQ2)};   pg8::gemm_phase(llds, g, S, E, wv); }
        GSYNC();
        { pg8::Gemm g{(const bf16_t*)(ws + WS_KV), (const bf16_t*)(ws + WS_WT_G) + (size_t)l * 2048 * 2048, T, 2048, 2048}; pg8::StaticOrder S; S.init(T, 2048, G, (int)blockIdx.x);
          pg8::EpiGate E{kp_fresh()->out, PPb, (const float*)(ws + WS_SSQ2)}; pg8::gemm_phase(llds, g, S, E, wv); }
        if (l + 1 < DEPTH) GSYNC();
    }
}

extern "C" void kernel_launch(void* const* d_in, const int* in_sizes, int n_in, void* d_out, int out_size, void* d_ws, size_t ws_size, hipStream_t stream) {
    static int grid_blocks = 0;
    if (grid_blocks == 0) {
        if (n_in != 21 || out_size != T * D_MODEL || ws_size < WS_END) { fprintf(stderr, "kernel_launch: unexpected shapes (n_in %d, out %d, ws %zu need %zu)\n", n_in, out_size, ws_size, (size_t)WS_END); grid_blocks = -1; return; }
        int dev = 0, cus = 0, per_cu = 0;
        hipGetDevice(&dev); hipDeviceGetAttribute(&cus, hipDeviceAttributeMultiprocessorCount, dev);
        if (hipFuncSetAttribute((const void*)fwd_megakernel, hipFuncAttributeMaxDynamicSharedMemorySize, LDS_BYTES) != hipSuccess) { fprintf(stderr, "kernel_launch: hipFuncSetAttribute failed\n"); grid_blocks = -1; return; }
        hipOccupancyMaxActiveBlocksPerMultiprocessor(&per_cu, (const void*)fwd_megakernel, NTHR, LDS_BYTES);
        if (per_cu < 1) { fprintf(stderr, "kernel_launch: occupancy query says %d blocks per CU\n", per_cu); per_cu = 1; }
        if (per_cu > 1) per_cu = 1;
        grid_blocks = cus * per_cu;
    }
    if (grid_blocks < 0) return;
    Params P{};
    P.x = (const float*)d_in[0]; P.p = (const float*)d_in[1]; P.positions = (const int*)d_in[2]; P.attn_norm = (const float*)d_in[3]; P.w_in = (const float*)d_in[4];
    P.sgu_norm = (const float*)d_in[5]; P.w_spatial = (const float*)d_in[6]; P.b_spatial = (const float*)d_in[7]; P.conv_w = (const float*)d_in[8]; P.conv_b = (const float*)d_in[9];
    P.kv_norm = (const float*)d_in[10]; P.w_ukv = (const float*)d_in[11]; P.q_nope_norm = (const float*)d_in[12]; P.q_rope_norm = (const float*)d_in[13];
    P.k_nope_norm = (const float*)d_in[14]; P.k_rope_norm = (const float*)d_in[15]; P.out_norm = (const float*)d_in[16]; P.w_out = (const float*)d_in[17];
    P.ple_norm = (const float*)d_in[18]; P.w_ple_gate = (const float*)d_in[19]; P.w_ple_proj = (const float*)d_in[20]; P.out = (float*)d_out; P.ws = (unsigned char*)d_ws;
    if (hipMemsetAsync((unsigned char*)d_ws + WS_BAR, 0, 16384, stream) != hipSuccess) { fprintf(stderr, "kernel_launch: memset failed\n"); return; }
    void* args[] = {&P};
    hipError_t e = hipLaunchCooperativeKernel((const void*)fwd_megakernel, dim3(grid_blocks), dim3(NTHR), args, LDS_BYTES, stream);
    if (e != hipSuccess) fprintf(stderr, "kernel_launch: cooperative launch failed: %s (grid %d)\n", hipGetErrorString(e), grid_blocks);
}
```

```cpp
#include <hip/hip_runtime.h>
#include <hip/hip_cooperative_groups.h>
#include <cstdio>
#include <cstdint>
namespace cg = cooperative_groups;

constexpr int D_MODEL = 2048, BATCH = 2, SEQ = 8192, DEPTH = 4, T = BATCH * SEQ;
constexpr int PLE = 256, IN_W = 6720, LDP = 6912  ;
constexpr int OFF_AU = 0, OFF_AV = 512, OFF_AZ = 1024, OFF_BB = 1536, OFF_BC = 2048, OFF_BH = 2560, OFF_BZ = 3072,
              OFF_CQ = 3584, OFF_CKV = 5120, OFF_CKR = 5632, OFF_CZ = 5696;
constexpr float EPS = 1e-6f;
constexpr int NTHR = 512;
constexpr int YC = 0, YA = 1024, YB = 1536;

typedef unsigned short bf16_t;
typedef short bf16x8 __attribute__((ext_vector_type(8)));
typedef short s16x4 __attribute__((ext_vector_type(4)));
typedef float f32x4 __attribute__((ext_vector_type(4)));
typedef float f32x16 __attribute__((ext_vector_type(16)));
typedef unsigned u32x4 __attribute__((ext_vector_type(4)));
typedef unsigned u32x2 __attribute__((ext_vector_type(2)));

constexpr size_t SZ_WT_IN = (size_t)DEPTH * LDP * 2048 * 2, SZ_WT_UKV = (size_t)DEPTH * 2048 * 512 * 2, SZ_WT_SQ = (size_t)DEPTH * 2048 * 2048 * 2,
                 SZ_WT_PP = (size_t)DEPTH * 2048 * 256 * 2, SZ_PB = (size_t)DEPTH * T * 256 * 2, SZ_ACT = (size_t)T * 2048 * 2,
                 SZ_PROJ = (size_t)T * LDP * 2, SZ_CKVN = (size_t)T * 512 * 2, SZ_QK = (size_t)BATCH * 8 * SEQ * 192 * 2, SZ_ROPE = (size_t)T * 32 * 4;
constexpr size_t WS_WT_IN = 0, WS_WT_UKV = WS_WT_IN + SZ_WT_IN, WS_WT_OUT = WS_WT_UKV + SZ_WT_UKV, WS_WT_G = WS_WT_OUT + SZ_WT_SQ,
                 WS_WT_PP = WS_WT_G + SZ_WT_SQ, WS_PB = WS_WT_PP + SZ_WT_PP, WS_Y = WS_PB + SZ_PB  , WS_PROJ = WS_Y + SZ_ACT,
                 WS_PP = WS_PROJ + SZ_PROJ, WS_CKVN = WS_PP + SZ_ACT, WS_KV = WS_CKVN + SZ_CKVN, WS_Q = WS_KV + SZ_ACT, WS_K = WS_Q + SZ_QK,
                 WS_COS = WS_K + SZ_QK, WS_SIN = WS_COS + SZ_ROPE, WS_BAR = WS_SIN + SZ_ROPE, WS_SSQA = WS_BAR + 16384, WS_SSQC = WS_SSQA + (size_t)T * 4 * 4, WS_SSQ2 = WS_SSQC + (size_t)T * 8 * 4, WS_END = WS_SSQ2 + (size_t)T * 32 * 4;

struct Params {
    const float* x; const float* p; const int* positions; const float* attn_norm; const float* w_in; const float* sgu_norm; const float* w_spatial;
    const float* b_spatial; const float* conv_w; const float* conv_b; const float* kv_norm; const float* w_ukv; const float* q_nope_norm;
    const float* q_rope_norm; const float* k_nope_norm; const float* k_rope_norm; const float* out_norm; const float* w_out; const float* ple_norm;
    const float* w_ple_gate; const float* w_ple_proj; float* out; unsigned char* ws;
};

__device__ __forceinline__ int otid() { int t = threadIdx.x; asm volatile("" : "+v"(t)); return t; }
__device__ __forceinline__ float bf2f(bf16_t u) { return __uint_as_float(((unsigned)u) << 16); }
__device__ __forceinline__ float bflo(unsigned w) { return __uint_as_float(w << 16); }
__device__ __forceinline__ float bfhi(unsigned w) { return __uint_as_float(w & 0xffff0000u); }
__device__ __forceinline__ unsigned cvt_pk_bf16(float lo, float hi) { unsigned r; asm volatile("v_cvt_pk_bf16_f32 %0, %1, %2" : "=v"(r) : "v"(lo), "v"(hi)); return r; }
__device__ __forceinline__ bf16_t f2bf(float f) { return (bf16_t)(cvt_pk_bf16(f, 0.f) & 0xffffu); }
__device__ __forceinline__ float wave_sum(float v) { v += __shfl_xor(v, 32); v += __shfl_xor(v, 16); v += __shfl_xor(v, 8); v += __shfl_xor(v, 4); v += __shfl_xor(v, 2); v += __shfl_xor(v, 1); return v; }
__device__ __forceinline__ float sum8(float v) { v += __shfl_xor(v, 4); v += __shfl_xor(v, 2); v += __shfl_xor(v, 1); return v; }
__device__ __forceinline__ float silu(float z) { return z / (1.f + __expf(-z)); }
__device__ __forceinline__ float sigmoidf(float z) { return 1.f / (1.f + __expf(-z)); }
__device__ __forceinline__ void unpack8(u32x4 w, float* f) { f[0] = bflo(w.x); f[1] = bfhi(w.x); f[2] = bflo(w.y); f[3] = bfhi(w.y); f[4] = bflo(w.z); f[5] = bfhi(w.z); f[6] = bflo(w.w); f[7] = bfhi(w.w); }
__device__ __forceinline__ u32x4 pack8(const float* f) { u32x4 w; w.x = cvt_pk_bf16(f[0], f[1]); w.y = cvt_pk_bf16(f[2], f[3]); w.z = cvt_pk_bf16(f[4], f[5]); w.w = cvt_pk_bf16(f[6], f[7]); return w; }

namespace pg8 {
#define PG8_LAS __attribute__((address_space(3)))
constexpr int BM = 256, BK = 64, HALF = 128, HTB = HALF * BK * 2, STAGE_BYTES = 8 * HTB, NXCD = 8, WGM = 8;
__host__ __device__ __forceinline__ int lds_byte(int r, int c) { const int st = (r >> 4) * 2 + (c >> 5), rr = r & 15, cc = c & 31, ob = rr * 64 + cc * 2; return st * 1024 + (ob ^ (((ob >> 9) & 1) << 5)); }
__host__ __device__ __forceinline__ void stage_rc(int b, int& R, int& C) { const int st = b / 1024, sb = b % 1024, swz = sb ^ (((sb >> 9) & 1) << 5); R = (st >> 1) * 16 + swz / 64; C = (st & 1) * 32 + (swz % 64) / 2; }
__host__ __device__ __forceinline__ int perm32(int rho) { const int n = rho >> 4, i = rho & 15; return 8 * (i >> 2) + 4 * n + (i & 3); }
struct Unit { int pm, pn; };
struct Gemm { const bf16_t* A; const bf16_t* Bt; int M, N, K; };
struct StaticOrder {
    int nM, nN, nwg, G, c;
    __device__ void init(int M, int N, int G_, int c_) { nM = M / BM; nN = N / BM; nwg = nM * nN; G = G_; c = c_; }
    __device__ bool next(int i, Unit& u) const {
        const long L = (long)i * G + c; if (L >= nwg) return false;
        int wgid = (int)L; { const int q = nwg / NXCD, r = nwg % NXCD, xcd = wgid % NXCD, off = wgid / NXCD; wgid = (xcd < r ? xcd * (q + 1) : r * (q + 1) + (xcd - r) * q) + off; }
        const int nig = WGM * nN, gid = wgid / nig, fm = gid * WGM, gsz = (nM - fm) < WGM ? (nM - fm) : WGM;
        u.pm = fm + ((wgid % nig) % gsz); u.pn = (wgid % nig) / gsz; return true;
    }
};
template <class Epi>
__device__ __forceinline__ void gemm_phase(PG8_LAS unsigned char* lds, const Gemm g, const StaticOrder& S, const Epi& E) {
    const int tid = otid(), wid = __builtin_amdgcn_readfirstlane(tid >> 6), lane = tid & 63, wr = wid >> 2, wc = wid & 3, fr = lane & 15, fq = lane >> 4;
    const int K = g.K, nt = K / BK;
    unsigned voffA[2], voffB[2];
#pragma unroll
    for (int i = 0; i < 2; ++i) { int R, C; stage_rc(tid * 16 + i * 8192, R, C); const int Rb = Epi::PERM ? ((R & ~31) + perm32(R & 31)) : R;
        voffA[i] = (unsigned)(R * K + C) * 2u; voffB[i] = (unsigned)(Rb * K + C) * 2u; }
    const size_t kstep = (size_t)(BK * 2);
    const size_t hstep = (size_t)HALF * K * 2;
    const size_t tstep = 2 * hstep;
    const unsigned ldsw = (unsigned)wid * 1024u;
    const int aoff = lds_byte(wr * 64 + fr, fq * 8), boff = lds_byte(wc * 32 + fr, fq * 8);
#define PG8_SA(b, h) (((b) * 2 + (h)) * HTB)
#define PG8_SB(b, h) ((4 + (b) * 2 + (h)) * HTB)
#define PG8_STAGE(bufoff, gbase, voff) do { _Pragma("unroll") for (int _i = 0; _i < 2; ++_i) \
        __builtin_amdgcn_global_load_lds((const unsigned*)((const char*)(gbase) + (voff)[_i]), (PG8_LAS unsigned*)(lds + (bufoff) + ldsw + _i * 8192), 16, 0, 0); } while (0)
#define PG8_LDA(dst, b, h) do { _Pragma("unroll") for (int m = 0; m < 4; ++m) _Pragma("unroll") for (int k = 0; k < 2; ++k) dst[m][k] = *(const PG8_LAS bf16x8*)(lds + PG8_SA(b, h) + aoff + m * 2048 + k * 1024); } while (0)
#define PG8_LDB(dst, b, h) do { _Pragma("unroll") for (int n = 0; n < 2; ++n) _Pragma("unroll") for (int k = 0; k < 2; ++k) dst[n][k] = *(const PG8_LAS bf16x8*)(lds + PG8_SB(b, h) + boff + n * 2048 + k * 1024); } while (0)
#define PG8_MMA(ai, bj, At, Bt) do { __builtin_amdgcn_s_setprio(1); _Pragma("unroll") for (int m = 0; m < 4; ++m) _Pragma("unroll") for (int n = 0; n < 2; ++n) _Pragma("unroll") for (int k = 0; k < 2; ++k) \
        acc[ai][bj][m][n] = __builtin_amdgcn_mfma_f32_16x16x32_bf16(Bt[n][k], At[m][k], acc[ai][bj][m][n], 0, 0, 0); __builtin_amdgcn_s_setprio(0); } while (0)
#define PG8_WAIT_V(n) asm volatile("s_waitcnt vmcnt(" #n ")" ::: "memory")
#define PG8_WAIT_L(n) asm volatile("s_waitcnt lgkmcnt(" #n ")" ::: "memory")
#define PG8_BAR __builtin_amdgcn_s_barrier()
#define PG8_SCHED __builtin_amdgcn_sched_barrier(0)
    Unit cur, nxt; int ui = 0;
    if (!S.next(0, cur)) return;
    f32x4 acc[2][2][4][2];
#pragma unroll
    for (int a = 0; a < 2; ++a)
#pragma unroll
        for (int b = 0; b < 2; ++b)
#pragma unroll
            for (int m = 0; m < 4; ++m)
#pragma unroll
                for (int n = 0; n < 2; ++n) acc[a][b][m][n] = (f32x4){0.f, 0.f, 0.f, 0.f};
    bf16x8 At[4][2], B0[2][2], B1[2][2];
    float hk[8];
    const char* cA = (const char*)g.A + (size_t)cur.pm * tstep; const char* cB = (const char*)g.Bt + (size_t)cur.pn * tstep;
    PG8_STAGE(PG8_SB(0, 0), cB, voffB); PG8_STAGE(PG8_SA(0, 0), cA, voffA); PG8_STAGE(PG8_SB(0, 1), cB + hstep, voffB); PG8_STAGE(PG8_SA(0, 1), cA + hstep, voffA);
    if (wr == 1) PG8_BAR;
    PG8_WAIT_V(4); PG8_BAR;
    PG8_STAGE(PG8_SB(1, 0), cB + kstep, voffB); PG8_STAGE(PG8_SA(1, 0), cA + kstep, voffA); PG8_STAGE(PG8_SB(1, 1), cB + hstep + kstep, voffB);
    PG8_WAIT_V(6); PG8_BAR;
    for (;;) {
        const bool has_next = S.next(ui + 1, nxt);
        const char* nA = has_next ? (const char*)g.A + (size_t)nxt.pm * tstep : cA; const char* nB = has_next ? (const char*)g.Bt + (size_t)nxt.pn * tstep : cB;
        constexpr int NSEG = Epi::HOOKS ? 3 : 1;
#pragma unroll
        for (int seg = 0; seg < NSEG; ++seg) {
        int tb = 0, te = nt;
        if constexpr (Epi::HOOKS) { tb = (seg == 0) ? 0 : (seg == 1 ? Epi::T1 : Epi::T2); te = (seg == 0) ? Epi::T1 : (seg == 1 ? Epi::T2 : nt);
            if (seg == 1) { PG8_SCHED; E.hook1(acc, hk, cur, wr, lane); PG8_SCHED; } if (seg == 2) { PG8_SCHED; E.hook2(acc, hk); PG8_SCHED; } }
        for (int t = tb; t < te; t += 2) {
            const bool last = (t == nt - 2);
            const char* a1 = cA + (size_t)(t + 1) * kstep;
            const char* a2 = last ? nA : cA + (size_t)(t + 2) * kstep; const char* b2 = last ? nB : cB + (size_t)(t + 2) * kstep;
            const char* a3 = a2 + kstep; const char* b3 = b2 + kstep;
            PG8_LDB(B0, 0, 0); PG8_SCHED; PG8_LDA(At, 0, 0); PG8_STAGE(PG8_SA(1, 1), a1 + hstep, voffA);
            PG8_WAIT_L(8); PG8_BAR; PG8_WAIT_L(0); PG8_MMA(0, 0, At, B0); PG8_BAR; PG8_SCHED;
            PG8_LDB(B1, 0, 1); PG8_STAGE(PG8_SB(0, 0), b2, voffB);
            PG8_BAR; PG8_WAIT_L(0); PG8_MMA(0, 1, At, B1); PG8_BAR;
            PG8_LDA(At, 0, 1); PG8_STAGE(PG8_SA(0, 0), a2, voffA);
            PG8_BAR; PG8_WAIT_L(0); PG8_MMA(1, 0, At, B0); PG8_BAR; PG8_SCHED;
            PG8_STAGE(PG8_SB(0, 1), b2 + hstep, voffB);
            PG8_WAIT_V(6); PG8_BAR; PG8_MMA(1, 1, At, B1); PG8_BAR;
            PG8_LDB(B0, 1, 0); PG8_SCHED; PG8_LDA(At, 1, 0); PG8_STAGE(PG8_SA(0, 1), a2 + hstep, voffA);
            PG8_WAIT_L(8); PG8_BAR; PG8_WAIT_L(0); PG8_MMA(0, 0, At, B0); PG8_BAR; PG8_SCHED;
            PG8_LDB(B1, 1, 1); PG8_STAGE(PG8_SB(1, 0), b3, voffB);
            PG8_BAR; PG8_WAIT_L(0); PG8_MMA(0, 1, At, B1); PG8_BAR;
            PG8_LDA(At, 1, 1); PG8_STAGE(PG8_SA(1, 0), a3, voffA);
            PG8_BAR; PG8_WAIT_L(0); PG8_MMA(1, 0, At, B0); PG8_BAR; PG8_SCHED;
            PG8_STAGE(PG8_SB(1, 1), b3 + hstep, voffB);
            PG8_WAIT_V(6); PG8_BAR; PG8_MMA(1, 1, At, B1); PG8_BAR;
        }
        }
        E(acc, cur, wr, wc, fr, fq);
        if (!has_next) break;
#pragma unroll
        for (int a = 0; a < 2; ++a)
#pragma unroll
            for (int b = 0; b < 2; ++b)
#pragma unroll
                for (int m = 0; m < 4; ++m)
#pragma unroll
                    for (int n = 0; n < 2; ++n) acc[a][b][m][n] = (f32x4){0.f, 0.f, 0.f, 0.f};
        cur = nxt; cA = nA; cB = nB; ++ui;
    }
    PG8_WAIT_V(0);
    if (wr == 0) PG8_BAR;
    PG8_BAR;
#undef PG8_SA
#undef PG8_SB
#undef PG8_STAGE
#undef PG8_LDA
#undef PG8_LDB
#undef PG8_MMA
#undef PG8_WAIT_V
#undef PG8_WAIT_L
#undef PG8_BAR
#undef PG8_SCHED
}

struct EpiBf16Store {
    static constexpr bool PERM = true; static constexpr bool HOOKS = false;
    bf16_t* O; int ldc;
    __device__ __forceinline__ void operator()(const f32x4 (&acc)[2][2][4][2], const Unit& u, int wr, int wc, int fr, int fq) const {
        const int row0 = u.pm * BM + wr * 64 + fr, col0 = u.pn * BM + wc * 32 + 8 * fq;
#pragma unroll
        for (int ai = 0; ai < 2; ++ai)
#pragma unroll
            for (int m = 0; m < 4; ++m) { bf16_t* rowp = O + (size_t)(row0 + ai * HALF + m * 16) * ldc + col0;
#pragma unroll
                for (int bj = 0; bj < 2; ++bj) { const f32x4 v0 = acc[ai][bj][m][0], v1 = acc[ai][bj][m][1];
                    u32x4 w; w.x = cvt_pk_bf16(v0[0], v0[1]); w.y = cvt_pk_bf16(v0[2], v0[3]); w.z = cvt_pk_bf16(v1[0], v1[1]); w.w = cvt_pk_bf16(v1[2], v1[3]);
                    *(u32x4*)(rowp + bj * HALF) = w; } }
    }
};
struct EpiResF32 {
    static constexpr bool PERM = false; static constexpr bool HOOKS = false;
    const float* in; float* out;
    __device__ __forceinline__ void operator()(const f32x4 (&acc)[2][2][4][2], const Unit& u, int wr, int wc, int fr, int fq) const {
        const int row0 = u.pm * BM + wr * 64 + fr, col0 = u.pn * BM + wc * 32 + 4 * fq;
#pragma unroll
        for (int ai = 0; ai < 2; ++ai)
#pragma unroll
            for (int m = 0; m < 4; ++m) { const size_t ro = (size_t)(row0 + ai * HALF + m * 16) * D_MODEL + col0;
#pragma unroll
                for (int bj = 0; bj < 2; ++bj)
#pragma unroll
                    for (int n = 0; n < 2; ++n) { const f32x4 r = *(const f32x4*)(in + ro + bj * HALF + n * 16); *(f32x4*)(out + ro + bj * HALF + n * 16) = r + acc[ai][bj][m][n]; } }
    }
};
struct EpiGate {
    static constexpr bool PERM = false; static constexpr bool HOOKS = false;
    float* h; const bf16_t* pp; const float* ssq_in;
    __device__ __forceinline__ void operator()(const f32x4 (&acc)[2][2][4][2], const Unit& u, int wr, int wc, int fr, int fq) const {
        int lx = fr | (fq << 4); asm volatile("" : "+v"(lx));
        const int frx = lx & 15, fqx = lx >> 4;
        const int row0 = u.pm * BM + wr * 64 + frx, col0 = u.pn * BM + wc * 32 + 4 * fqx;
#pragma unroll
        for (int ai = 0; ai < 2; ++ai) {
            float rs[4];
#pragma unroll
            for (int m = 0; m < 4; ++m) { const float* sp = ssq_in + ((row0 + ai * HALF + m * 16) * 32 + fqx * 8); const f32x4 a = *(const f32x4*)sp, b = *(const f32x4*)(sp + 4);
                float t = ((a[0] + a[1]) + (a[2] + a[3])) + ((b[0] + b[1]) + (b[2] + b[3])); t += __shfl_xor(t, 16); t += __shfl_xor(t, 32); rs[m] = rsqrtf(t * (1.f / 2048.f) + EPS); }
#pragma unroll
            for (int m = 0; m < 4; ++m) { const size_t ro = (size_t)(row0 + ai * HALF + m * 16) * D_MODEL + col0; const float rr = rs[m];
#pragma unroll
                for (int bj = 0; bj < 2; ++bj)
#pragma unroll
                    for (int n = 0; n < 2; ++n) { const size_t o = ro + bj * HALF + n * 16; const f32x4 r = *(const f32x4*)(h + o); const u32x2 pw = *(const u32x2*)(pp + o);
                        const f32x4 a = acc[ai][bj][m][n] * rr; f32x4 v;
                        v[0] = r[0] + sigmoidf(a[0]) * bflo(pw.x); v[1] = r[1] + sigmoidf(a[1]) * bfhi(pw.x); v[2] = r[2] + sigmoidf(a[2]) * bflo(pw.y); v[3] = r[3] + sigmoidf(a[3]) * bfhi(pw.y);
                        *(f32x4*)(h + o) = v; } } }
    }
};
struct EpiKV {
    static constexpr bool PERM = true; static constexpr bool HOOKS = false;
    bf16_t* Kb; bf16_t* KV; const float* kn_g; PG8_LAS float* xl;
    __device__ __forceinline__ void operator()(const f32x4 (&acc)[2][2][4][2], const Unit& u, int wr, int wc, int fr, int fq) const {
        const int rl0 = wr * 64 + fr, c0 = wc * 32 + 8 * fq, h = u.pn;
#pragma unroll
        for (int ai = 0; ai < 2; ++ai)
#pragma unroll
            for (int m = 0; m < 4; ++m) { const f32x4 a = acc[ai][0][m][0], b = acc[ai][0][m][1];
                float s = (a[0] * a[0] + a[1] * a[1]) + (a[2] * a[2] + a[3] * a[3]) + (b[0] * b[0] + b[1] * b[1]) + (b[2] * b[2] + b[3] * b[3]);
                s += __shfl_xor(s, 16); s += __shfl_xor(s, 32);
                if (fq == 0) xl[(ai * HALF + rl0 + m * 16) * 4 + wc] = s; }
        asm volatile("s_waitcnt lgkmcnt(0)" ::: "memory"); __builtin_amdgcn_s_barrier(); asm volatile("" ::: "memory");
        float g[8];
        { const f32x4 g0 = *(const f32x4*)(kn_g + c0), g1 = *(const f32x4*)(kn_g + c0 + 4);
#pragma unroll
          for (int j = 0; j < 4; ++j) { g[j] = g0[j]; g[4 + j] = g1[j]; } }
#pragma unroll
        for (int ai = 0; ai < 2; ++ai)
#pragma unroll
            for (int m = 0; m < 4; ++m) { const int rl = ai * HALF + rl0 + m * 16; const f32x4 p = *(const PG8_LAS f32x4*)(xl + rl * 4);
                const float rs = rsqrtf(((p[0] + p[1]) + (p[2] + p[3])) * (1.f / 128.f) + EPS);
                const int t = u.pm * BM + rl, b = t / SEQ, sq = t - b * SEQ;
                const f32x4 k0 = acc[ai][0][m][0] * rs, k1 = acc[ai][0][m][1] * rs, v0 = acc[ai][1][m][0], v1 = acc[ai][1][m][1];
                u32x4 w; w.x = cvt_pk_bf16(k0[0] * g[0], k0[1] * g[1]); w.y = cvt_pk_bf16(k0[2] * g[2], k0[3] * g[3]); w.z = cvt_pk_bf16(k1[0] * g[4], k1[1] * g[5]); w.w = cvt_pk_bf16(k1[2] * g[6], k1[3] * g[7]);
                *(u32x4*)(Kb + ((size_t)(b * 8 + h) * SEQ + sq) * 192 + c0) = w;
                u32x4 x; x.x = cvt_pk_bf16(v0[0], v0[1]); x.y = cvt_pk_bf16(v0[2], v0[3]); x.z = cvt_pk_bf16(v1[0], v1[1]); x.w = cvt_pk_bf16(v1[2], v1[3]);
                *(u32x4*)(KV + (size_t)t * 2048 + h * 256 + 128 + c0) = x; }
    }
};
struct EpiResMid {
    static constexpr bool PERM = false; static constexpr bool HOOKS = true; static constexpr int T1 = 16, T2 = 24;
    const float* in; float* out; const float* ssqa; const float* ssqc;
    bf16_t* hb; float* ssq2;
    __device__ __forceinline__ void hook1(f32x4 (&acc)[2][2][4][2], float (&hk)[8], const Unit& u, int wr, int fr) const {
        int frx = fr; asm volatile("" : "+v"(frx));
        const int row0 = u.pm * BM + wr * 64 + (frx & 15), fq = (frx >> 4) & 3;
        typedef float f32x2 __attribute__((ext_vector_type(2)));
#pragma unroll
        for (int ai = 0; ai < 2; ++ai) {
            float cs[4], as_[4];
#pragma unroll
            for (int m = 0; m < 4; ++m) { const int row = row0 + ai * HALF + m * 16; const f32x2 c = *(const f32x2*)(ssqc + (row * 8 + fq * 2)); cs[m] = c.x + c.y; as_[m] = ssqa[row * 4 + fq]; }
#pragma unroll
            for (int m = 0; m < 4; ++m) { cs[m] += __shfl_xor(cs[m], 16); cs[m] += __shfl_xor(cs[m], 32); as_[m] += __shfl_xor(as_[m], 16); as_[m] += __shfl_xor(as_[m], 32); }
#pragma unroll
            for (int m = 0; m < 4; ++m) {
                const float rsC = rsqrtf(cs[m] * (1.f / 1024.f) + EPS); const float sA = as_[m] * (1.f / 512.f) + EPS; const float rsA = rsqrtf(sA);
                hk[ai * 4 + m] = rsA; const float f = rsC * sA * rsA;
#pragma unroll
                for (int bj = 0; bj < 2; ++bj)
#pragma unroll
                    for (int n = 0; n < 2; ++n) acc[ai][bj][m][n] = acc[ai][bj][m][n] * f; }
            __builtin_amdgcn_sched_barrier(0);
        }
    }
    __device__ __forceinline__ void hook2(f32x4 (&acc)[2][2][4][2], const float (&hk)[8]) const {
#pragma unroll
        for (int ai = 0; ai < 2; ++ai)
#pragma unroll
            for (int m = 0; m < 4; ++m)
#pragma unroll
                for (int bj = 0; bj < 2; ++bj)
#pragma unroll
                    for (int n = 0; n < 2; ++n) acc[ai][bj][m][n] = acc[ai][bj][m][n] * hk[ai * 4 + m];
    }
    __device__ __forceinline__ void operator()(const f32x4 (&acc)[2][2][4][2], const Unit& u, int wr, int wc, int fr, int fq) const {
        const int row0 = u.pm * BM + wr * 64 + fr, col0 = u.pn * BM + wc * 32 + 4 * fq;
#pragma unroll
        for (int ai = 0; ai < 2; ++ai)
#pragma unroll
            for (int m = 0; m < 4; ++m) { const int row = row0 + ai * HALF + m * 16; const size_t ro = (size_t)row * D_MODEL + col0; float ss = 0.f;
#pragma unroll
                for (int bj = 0; bj < 2; ++bj)
#pragma unroll
                    for (int n = 0; n < 2; ++n) { const size_t o = ro + bj * HALF + n * 16; const f32x4 v = *(const f32x4*)(in + o) + acc[ai][bj][m][n]; *(f32x4*)(out + o) = v;
                        u32x2 w; w.x = cvt_pk_bf16(v[0], v[1]); w.y = cvt_pk_bf16(v[2], v[3]); *(u32x2*)(hb + o) = w; ss += (v[0] * v[0] + v[1] * v[1]) + (v[2] * v[2] + v[3] * v[3]); }
                ss += __shfl_xor(ss, 16); ss += __shfl_xor(ss, 32);
                if (fq == 0) ssq2[row * 32 + u.pn * 4 + wc] = ss; }
    }
};
}


#define XB_TMO      128
#define XB_XCNT(j)  (256  + 64 * (j))
#define XB_XSUB(j)  (1280 + 64 * (j))
#define XB_XGEN(j)  (2304 + 64 * (j))
#define XB_TOP      3328
#define XB_TOPGEN   3392
#define XCD_BAR_WORDS 3456
#define XB_SPIN_CAP (1u << 22)
__device__ __forceinline__ unsigned xb_ld(unsigned* p)              { return __hip_atomic_load(p, __ATOMIC_RELAXED, __HIP_MEMORY_SCOPE_AGENT); }
__device__ __forceinline__ unsigned xb_add(unsigned* p, unsigned v) { return __hip_atomic_fetch_add(p, v, __ATOMIC_RELAXED, __HIP_MEMORY_SCOPE_AGENT); }
__device__ __forceinline__ unsigned xb_xcc_id() { return (unsigned)__builtin_amdgcn_s_getreg((3 << 11) | 20) & 0xFu; }
#define XB_SPIN(cond, bar) do { unsigned _sp = 0; while (cond) { __builtin_amdgcn_s_sleep(1); \
    if ((++_sp & 255u) == 0u) { if (xb_ld(&(bar)[XB_TMO])) break; if (_sp > XB_SPIN_CAP) { atomicAdd(&(bar)[XB_TMO], 1u); break; } } } } while (0)
struct XcdBarrier { unsigned* bar; unsigned x; volatile PG8_LAS unsigned* st; };
__device__ __forceinline__ XcdBarrier xcd_barrier_post(unsigned* bar, volatile PG8_LAS unsigned* st) {
    XcdBarrier b; b.bar = bar; b.x = xb_xcc_id(); b.st = st;
    if (threadIdx.x == 0) (void)xb_add(&bar[XB_XCNT(b.x)], 1u);
    return b;
}
__device__ __forceinline__ void xcd_barrier_complete(unsigned* bar, unsigned x, unsigned& nloc, unsigned& nx) {
    const unsigned G = gridDim.x * gridDim.y * gridDim.z;
    unsigned sum, cnt, mine, sp = 0u;
    for (;;) {
        sum = 0u; cnt = 0u; mine = 0u;
#pragma unroll
        for (unsigned j = 0; j < 16; ++j) { const unsigned c = xb_ld(&bar[XB_XCNT(j)]); sum += c; cnt += (c > 0u) ? 1u : 0u; mine = (j == x) ? c : mine; }
        if (sum == G) break;
        __builtin_amdgcn_s_sleep(1);
        if ((++sp & 255u) == 0u) { if (xb_ld(&bar[XB_TMO])) break; if (sp > XB_SPIN_CAP) { atomicAdd(&bar[XB_TMO], 1u); break; } }
    }
    nloc = mine > 0u ? mine : 1u; nx = cnt > 0u ? cnt : 1u;
}
__device__ __forceinline__ void xcd_barrier(const XcdBarrier& b) {
    asm volatile("s_waitcnt vmcnt(0)" ::: "memory");
    __syncthreads();
    if (threadIdx.x == 0) {
        unsigned* bar = b.bar;
        __builtin_amdgcn_s_waitcnt(0);
        unsigned nloc = b.st[0], nx = b.st[1];
        if (nloc == 0u) { xcd_barrier_complete(bar, b.x, nloc, nx); b.st[0] = nloc; b.st[1] = nx; }
        const unsigned old = xb_add(&bar[XB_XSUB(b.x)], 1u);
        const unsigned gen = old / nloc;
        if (old + 1u == (gen + 1u) * nloc) {
            __builtin_amdgcn_fence(__ATOMIC_RELEASE, "agent");
            asm volatile("s_waitcnt vmcnt(0)" ::: "memory");
            const unsigned og = xb_add(&bar[XB_TOP], 1u);
            const unsigned tg = og / nx;
            if (og + 1u == (tg + 1u) * nx) xb_add(&bar[XB_TOPGEN], 1u);
            else XB_SPIN(xb_ld(&bar[XB_TOPGEN]) == tg, bar);
            __builtin_amdgcn_fence(__ATOMIC_ACQUIRE, "agent");
            xb_add(&bar[XB_XGEN(b.x)], 1u);
            asm volatile("s_waitcnt vmcnt(0)" ::: "memory");
        } else {
            XB_SPIN(xb_ld(&bar[XB_XGEN(b.x)]) == gen, bar);
            __builtin_amdgcn_fence(__ATOMIC_ACQUIRE, "agent");
            asm volatile("s_waitcnt vmcnt(0)" ::: "memory");
        }
    }
    __syncthreads();
}

namespace att {
constexpr int DQ = 192, NW = 8, QBLK = 32, KVBLK = 64;
constexpr float SCALE = 0.07216878364870322f;
constexpr float THR = 8.f;
constexpr int LDQ = 192, LDK = 192, LDV = 2048;
constexpr int SHM_V = KVBLK * 128 * 2, SHM_K = KVBLK * DQ * 2, OFF_K = 3 * SHM_V, OFF_W = OFF_K + 3 * SHM_K, SHM_ATTN = OFF_W + NW * 64 * 4;
#define KSWZ(row, colB) ((row) * 384 + ((colB) ^ ((((row) >> 1) & 7) << 4)))
#define SBAR() __builtin_amdgcn_sched_barrier(0)
__device__ __forceinline__ int crow(int r, int hi) { return (r & 3) + 8 * (r >> 2) + 4 * hi; }
__device__ __forceinline__ void partialSM(f32x16& p0, f32x16& p1, float& m_reg, float& mn, float& alpha) {
    constexpr float C = SCALE * 1.4426950408889634f;
    float pmax = p0[0];
#pragma unroll
    for (int r = 1; r < 16; ++r) pmax = fmaxf(pmax, p0[r]);
#pragma unroll
    for (int r = 0; r < 16; ++r) pmax = fmaxf(pmax, p1[r]);
    { auto rr = __builtin_amdgcn_permlane32_swap(__float_as_uint(pmax), __float_as_uint(pmax), false, false);
      pmax = fmaxf(__uint_as_float(rr[0]), __uint_as_float(rr[1])); }
    if (__builtin_expect(__all(pmax - m_reg <= THR / SCALE), 1)) { mn = m_reg; alpha = 1.f; }
    else { mn = fmaxf(m_reg, pmax); alpha = __builtin_amdgcn_exp2f((m_reg - mn) * C); m_reg = mn; }
    float mnC = -mn * C;
#pragma unroll
    for (int r = 0; r < 16; ++r) p0[r] = fmaf(p0[r], C, mnC);
#pragma unroll
    for (int r = 0; r < 16; ++r) p1[r] = fmaf(p1[r], C, mnC);
#pragma unroll
    for (int r = 0; r < 16; ++r) p0[r] = __builtin_amdgcn_exp2f(p0[r]);
}
__device__ __forceinline__ void finishSM(f32x16& p0, f32x16& p1, float alpha, float& l_reg, bf16x8& pa0, bf16x8& pa1, bf16x8& pa2, bf16x8& pa3) {
#pragma unroll
    for (int r = 0; r < 16; ++r) p1[r] = __builtin_amdgcn_exp2f(p1[r]);
    float ps = 0;
#pragma unroll
    for (int r = 0; r < 16; ++r) ps += p0[r];
#pragma unroll
    for (int r = 0; r < 16; ++r) ps += p1[r];
    { auto rr = __builtin_amdgcn_permlane32_swap(__float_as_uint(ps), __float_as_uint(ps), false, false);
      ps = __uint_as_float(rr[0]) + __uint_as_float(rr[1]); }
    l_reg = l_reg * alpha + ps;
#define PK4(P, BASE, OUT) do { unsigned a0 = cvt_pk_bf16(P[BASE + 0], P[BASE + 1]), a1 = cvt_pk_bf16(P[BASE + 2], P[BASE + 3]);   \
    unsigned b0 = cvt_pk_bf16(P[BASE + 4], P[BASE + 5]), b1 = cvt_pk_bf16(P[BASE + 6], P[BASE + 7]);                              \
    auto r0 = __builtin_amdgcn_permlane32_swap(a0, b0, false, false); auto r1 = __builtin_amdgcn_permlane32_swap(a1, b1, false, false); \
    u32x4 w = {r0[0], r1[0], r0[1], r1[1]}; OUT = *reinterpret_cast<bf16x8*>(&w); } while (0)
    PK4(p0, 0, pa0); PK4(p0, 8, pa1); PK4(p1, 0, pa2); PK4(p1, 8, pa3);
#undef PK4
}
template <int OFF> __device__ __forceinline__ bf16x8 k_read(int a) { bf16x8 r; asm volatile("ds_read_b128 %0, %1 offset:%2" : "=&v"(r) : "v"(a), "i"(OFF) : "memory"); return r; }
constexpr int KDEPTH = 2;
template <int D0> __device__ __forceinline__ void k_pair(bf16x8& b0, bf16x8& b1, const int* ka) { b0 = k_read<(D0 >> 2) * 128>(ka[D0 & 3]); b1 = k_read<(D0 >> 2) * 128 + 32 * 384>(ka[D0 & 3]); }
template <int N> __device__ __forceinline__ void lgkm_wait(bf16x8& a, bf16x8& b) { asm volatile("s_waitcnt lgkmcnt(%2)" : "+v"(a), "+v"(b) : "n"(N) : "memory"); }
template <int D0> __device__ __forceinline__ void qkt_step(f32x16& p0, f32x16& p1, const bf16x8* qr, const int* ka, bf16x8 (&f0)[4], bf16x8 (&f1)[4]) {
    if constexpr (D0 + KDEPTH < 12) k_pair<D0 + KDEPTH>(f0[(D0 + KDEPTH) & 3], f1[(D0 + KDEPTH) & 3], ka);
    constexpr int younger = ((11 - D0) < KDEPTH ? (11 - D0) : KDEPTH) * 2;
    lgkm_wait<younger>(f0[D0 & 3], f1[D0 & 3]);
    p0 = __builtin_amdgcn_mfma_f32_32x32x16_bf16(f0[D0 & 3], qr[D0], p0, 0, 0, 0);
    p1 = __builtin_amdgcn_mfma_f32_32x32x16_bf16(f1[D0 & 3], qr[D0], p1, 0, 0, 0);
}
__device__ __forceinline__ void qkt(f32x16& p0, f32x16& p1, int kbase, const bf16x8* qr, const int* ko) {
    p0 = f32x16{}; p1 = f32x16{};
    int ka[4];
#pragma unroll
    for (int e = 0; e < 4; ++e) ka[e] = kbase + ko[e];
    bf16x8 f0[4], f1[4];
    k_pair<0>(f0[0], f1[0], ka); k_pair<1>(f0[1], f1[1], ka); if constexpr (KDEPTH > 2) k_pair<2>(f0[2], f1[2], ka);
    qkt_step<0>(p0, p1, qr, ka, f0, f1); qkt_step<1>(p0, p1, qr, ka, f0, f1); qkt_step<2>(p0, p1, qr, ka, f0, f1); qkt_step<3>(p0, p1, qr, ka, f0, f1);
    qkt_step<4>(p0, p1, qr, ka, f0, f1); qkt_step<5>(p0, p1, qr, ka, f0, f1); qkt_step<6>(p0, p1, qr, ka, f0, f1); qkt_step<7>(p0, p1, qr, ka, f0, f1);
    qkt_step<8>(p0, p1, qr, ka, f0, f1); qkt_step<9>(p0, p1, qr, ka, f0, f1); qkt_step<10>(p0, p1, qr, ka, f0, f1); qkt_step<11>(p0, p1, qr, ka, f0, f1);
}
__device__ __forceinline__ int v_st(int k, int c) { const int kk = (k & ~0xC) | ((k & 4) << 1) | ((k & 8) >> 1); return ((kk >> 3) * 4 + (c >> 5)) * 512 + ((kk & 7) * 32 + (c & 31)) * 2; }
__device__ __forceinline__ int v_rd_base(int lane) { return ((lane & 3) << 3) | (((lane >> 2) & 3) << 6) | (((lane >> 4) & 1) << 5) | (((lane >> 5) & 1) << 8); }
constexpr int v_rd_off(int d0, int ks, int half) { return d0 * 512 + ks * 4096 + half * 2048; }
template <int OFF> __device__ __forceinline__ s16x4 tr_read(int vb) {
    s16x4 r; asm volatile("ds_read_b64_tr_b16 %0, %1 offset:%2" : "=&v"(r) : "v"(vb), "i"(OFF) : "memory"); return r;
}
struct VFrag { s16x4 l0, h0, l1, h1, l2, h2, l3, h3; };
template <int D0> __device__ __forceinline__ void v_read8(VFrag& f, int vb) {
    f.l0 = tr_read<v_rd_off(D0, 0, 0)>(vb); f.h0 = tr_read<v_rd_off(D0, 0, 1)>(vb); f.l1 = tr_read<v_rd_off(D0, 1, 0)>(vb); f.h1 = tr_read<v_rd_off(D0, 1, 1)>(vb);
    f.l2 = tr_read<v_rd_off(D0, 2, 0)>(vb); f.h2 = tr_read<v_rd_off(D0, 2, 1)>(vb); f.l3 = tr_read<v_rd_off(D0, 3, 0)>(vb); f.h3 = tr_read<v_rd_off(D0, 3, 1)>(vb);
}
__device__ __forceinline__ void pv_mma4(f32x16& od, const VFrag& f, bf16x8 pa0, bf16x8 pa1, bf16x8 pa2, bf16x8 pa3) {
#define PK(L, H) (bf16x8){L[0], L[1], L[2], L[3], H[0], H[1], H[2], H[3]}
    od = __builtin_amdgcn_mfma_f32_32x32x16_bf16(pa0, PK(f.l0, f.h0), od, 0, 0, 0);
    od = __builtin_amdgcn_mfma_f32_32x32x16_bf16(pa1, PK(f.l1, f.h1), od, 0, 0, 0);
    od = __builtin_amdgcn_mfma_f32_32x32x16_bf16(pa2, PK(f.l2, f.h2), od, 0, 0, 0);
    od = __builtin_amdgcn_mfma_f32_32x32x16_bf16(pa3, PK(f.l3, f.h3), od, 0, 0, 0);
#undef PK
}
__device__ __forceinline__ void pv_d0(f32x16* o, int vb, bf16x8 pa0, bf16x8 pa1, bf16x8 pa2, bf16x8 pa3) {
    VFrag fa, fb;
    v_read8<0>(fa, vb); v_read8<1>(fb, vb);
    asm volatile("s_waitcnt lgkmcnt(8)" ::: "memory"); SBAR(); pv_mma4(o[0], fa, pa0, pa1, pa2, pa3); SBAR();
    v_read8<2>(fa, vb);
    asm volatile("s_waitcnt lgkmcnt(8)" ::: "memory"); SBAR(); pv_mma4(o[1], fb, pa0, pa1, pa2, pa3); SBAR();
    v_read8<3>(fb, vb);
    asm volatile("s_waitcnt lgkmcnt(8)" ::: "memory"); SBAR(); pv_mma4(o[2], fa, pa0, pa1, pa2, pa3); SBAR();
    asm volatile("s_waitcnt lgkmcnt(0)" ::: "memory"); SBAR(); pv_mma4(o[3], fb, pa0, pa1, pa2, pa3);
}
__device__ __forceinline__ void attn_body(const bf16_t* __restrict__ Qb, const bf16_t* __restrict__ Kh, const bf16_t* __restrict__ Vh,
                                          const bf16_t* __restrict__ Zb, bf16_t* __restrict__ Yb, float* __restrict__ Sq, int seq, char* lds) {
    const int tid = otid(), wid = __builtin_amdgcn_readfirstlane(tid >> 6), lane = tid & 63, r32 = lane & 31, hi = lane >> 5;
    PG8_LAS char* l3 = (PG8_LAS char*)lds;
    char* V_lds = lds; char* K_lds = lds + OFF_K;
    float* wsl = (float*)(lds + OFF_W) + wid * 64; float* li_l = wsl; float* al_l = wsl + 32;
    float m_reg = -1e30f, l_reg = 0; f32x16 o[4] = {}; bf16x8 qr[12];
    const bf16_t* Qw = Qb + (long)(wid * QBLK + r32) * LDQ + hi * 8;
#pragma unroll
    for (int d0 = 0; d0 < 12; ++d0) qr[d0] = *reinterpret_cast<const bf16x8*>(Qw + d0 * 16);
    int kg[3], vg[2];
#pragma unroll
    for (int i = 0; i < 3; ++i) { const int p = (wid * 3 + i) * 64 + lane, row = p / 24, cp = p % 24, c = cp ^ ((row >> 1) & 7); kg[i] = row * LDK + c * 8; }
#pragma unroll
    for (int i = 0; i < 2; ++i) { const int sl = (wid * 2 + i) * 64 + lane, kk = ((sl >> 7) << 3) | ((sl >> 2) & 7), c = ((sl >> 5) & 3) * 32 + (sl & 3) * 8;
        const int k = (kk & ~0xC) | ((kk & 4) << 1) | ((kk & 8) >> 1); vg[i] = k * LDV + c; }
    const int vb0 = (int)(uintptr_t)V_lds + v_rd_base(lane);
    const int klds_i = (int)(uintptr_t)K_lds;
    int ko[4];
#pragma unroll
    for (int e = 0; e < 4; ++e) ko[e] = r32 * 384 + (((e * 2 + hi) ^ ((r32 >> 1) & 7)) << 4);
#define KISSUE(tile, buf) do { const bf16_t* Kt_ = Kh + (size_t)(tile) * (KVBLK * LDK); _Pragma("unroll") for (int i_ = 0; i_ < 3; ++i_) \
    __builtin_amdgcn_global_load_lds((const unsigned*)(Kt_ + kg[i_]), (PG8_LAS unsigned*)(l3 + OFF_K + (buf) * SHM_K + (wid * 3 + i_) * 1024), 16, 0, 0); } while (0)
#define VISSUE(tile, buf) do { const bf16_t* Vt_ = Vh + (size_t)(tile) * (KVBLK * LDV); _Pragma("unroll") for (int i_ = 0; i_ < 2; ++i_) \
    __builtin_amdgcn_global_load_lds((const unsigned*)(Vt_ + vg[i_]), (PG8_LAS unsigned*)(l3 + (buf) * SHM_V + (wid * 2 + i_) * 1024), 16, 0, 0); } while (0)
#define WAITV(n) asm volatile("s_waitcnt vmcnt(" #n ")" ::: "memory")
#define WBAR() do { __builtin_amdgcn_s_barrier(); asm volatile("" ::: "memory"); } while (0)
#define NEXT3(x) ((x) == 2 ? 0 : (x) + 1)
#define RESC(a) do { if (__any((a) < 1.f)) { if (hi == 0) al_l[r32] = (a); asm volatile("s_waitcnt lgkmcnt(0)" ::: "memory"); \
    _Pragma("unroll") for (int d = 0; d < 4; ++d) _Pragma("unroll") for (int r = 0; r < 16; ++r) o[d][r] *= al_l[crow(r, hi)]; } } while (0)
    f32x16 pA0, pA1, pB0, pB1; float mnA, mnB, alA, alB; bf16x8 pa0, pa1, pa2, pa3; const int NT = seq / KVBLK;
    WAITV(0);
    KISSUE(0, 0);
    KISSUE(1, 1); VISSUE(0, 0);
    WAITV(5); WBAR();
    KISSUE(2, 2); VISSUE(1, 1);
    qkt(pA0, pA1, klds_i, qr, ko); partialSM(pA0, pA1, m_reg, mnA, alA);
    int kb = 1, vbi = 0;
    for (int j = 1; j + 1 < NT; j += 2) {
        WAITV(5); WBAR();
        { const int k2 = NEXT3(NEXT3(kb)), v1 = NEXT3(NEXT3(vbi)); KISSUE(j + 2, k2); VISSUE(j + 1, v1); }
        SBAR(); qkt(pB0, pB1, klds_i + kb * SHM_K, qr, ko);
        finishSM(pA0, pA1, alA, l_reg, pa0, pa1, pa2, pa3); SBAR();
        pv_d0(o, vb0 + vbi * SHM_V, pa0, pa1, pa2, pa3); partialSM(pB0, pB1, m_reg, mnB, alB);
        RESC(alB);
        kb = NEXT3(kb); vbi = NEXT3(vbi);
        WAITV(5); WBAR();
        { const int k2 = NEXT3(NEXT3(kb)), v1 = NEXT3(NEXT3(vbi)); if (j + 3 < NT) KISSUE(j + 3, k2); VISSUE(j + 2, v1); }
        SBAR(); qkt(pA0, pA1, klds_i + kb * SHM_K, qr, ko);
        finishSM(pB0, pB1, alB, l_reg, pa0, pa1, pa2, pa3); SBAR();
        pv_d0(o, vb0 + vbi * SHM_V, pa0, pa1, pa2, pa3); partialSM(pA0, pA1, m_reg, mnA, alA);
        RESC(alA);
        kb = NEXT3(kb); vbi = NEXT3(vbi);
    }
    WAITV(0); WBAR();
    SBAR(); qkt(pB0, pB1, klds_i + kb * SHM_K, qr, ko);
    finishSM(pA0, pA1, alA, l_reg, pa0, pa1, pa2, pa3); SBAR();
    pv_d0(o, vb0 + vbi * SHM_V, pa0, pa1, pa2, pa3); partialSM(pB0, pB1, m_reg, mnB, alB);
    RESC(alB);
    vbi = NEXT3(vbi);
    finishSM(pB0, pB1, alB, l_reg, pa0, pa1, pa2, pa3); SBAR();
    pv_d0(o, vb0 + vbi * SHM_V, pa0, pa1, pa2, pa3);
    if (hi == 0) li_l[r32] = l_reg; asm volatile("s_waitcnt lgkmcnt(0)" ::: "memory");
    int er = wid * QBLK + 4 * hi; asm volatile("" : "+v"(er));
#pragma unroll
    for (int r = 0; r < 16; ++r) { const int ro = er + (r & 3) + 8 * (r >> 2); const float rli = __builtin_amdgcn_rcpf(li_l[ro - wid * QBLK]);
        const bf16_t* zp = Zb + ro * LDP + r32; bf16_t* yp = Yb + ro * 2048 + r32; float sq = 0.f;
#pragma unroll
        for (int d0 = 0; d0 < 4; ++d0) { const float z = bf2f(zp[d0 * 32]); const float y = o[d0][r] * rli * silu(z); sq += y * y; yp[d0 * 32] = f2bf(y); }
        sq += __shfl_xor(sq, 1); sq += __shfl_xor(sq, 2); sq += __shfl_xor(sq, 4); sq += __shfl_xor(sq, 8); sq += __shfl_xor(sq, 16);
        if (r32 == 0) Sq[ro * 8] = sq; }
    __syncthreads();
#undef KISSUE
#undef VISSUE
#undef WAITV
#undef WBAR
#undef NEXT3
#undef RESC
}
}

struct TrJob { const float* W; const float* gain; bf16_t* Wt; int K, N, Npad, krot; };
__device__ __forceinline__ void tr_load(const TrJob& J, int tile, int tid, f32x4 (&v)[8]) {
    const int ntn = J.Npad / 128, tk = tile / ntn, tn = tile % ntn, k0 = tk * 128, n0 = tn * 128, c4 = (tid & 31) * 4, r0 = tid >> 5;
#pragma unroll
    for (int i = 0; i < 8; ++i) { const int k = k0 + r0 + i * 16; f32x4 x = (f32x4){0.f, 0.f, 0.f, 0.f};
        if (n0 + c4 < J.N) { x = *(const f32x4*)(J.W + (size_t)k * J.N + n0 + c4); if (J.gain) { const float g = J.gain[k]; x = x * g; } }
        v[i] = x; }
}
constexpr int TR_IN = (2048 / 128) * (LDP / 128), TR_UKV = (512 / 128) * (2048 / 128), TR_SQ = (2048 / 128) * (2048 / 128), TR_PP = (256 / 128) * (2048 / 128);
constexpr int TR_E0 = DEPTH * TR_IN, TR_E1 = TR_E0 + DEPTH * TR_UKV, TR_E2 = TR_E1 + DEPTH * TR_SQ, TR_E3 = TR_E2 + DEPTH * TR_SQ, TR_E4 = TR_E3 + DEPTH * TR_PP;
__device__ __forceinline__ TrJob tr_decode(const Params& P, int g, int& tile) {
    unsigned char* ws = P.ws; TrJob J;
    if (g < TR_E0) { const int l = g / TR_IN; tile = g - l * TR_IN; J = TrJob{P.w_in + (size_t)l * 2048 * IN_W, P.attn_norm + l * 2048, (bf16_t*)(ws + WS_WT_IN) + (size_t)l * LDP * 2048, 2048, IN_W, LDP, 0}; }
    else if (g < TR_E1) { const int q = g - TR_E0, l = q / TR_UKV; tile = q - l * TR_UKV; J = TrJob{P.w_ukv + (size_t)l * 512 * 2048, P.kv_norm + l * 512, (bf16_t*)(ws + WS_WT_UKV) + (size_t)l * 2048 * 512, 512, 2048, 2048, 0}; }
    else if (g < TR_E2) { const int q = g - TR_E1, l = q / TR_SQ; tile = q - l * TR_SQ; J = TrJob{P.w_out + (size_t)l * 2048 * 2048, P.out_norm + l * 2048, (bf16_t*)(ws + WS_WT_OUT) + (size_t)l * 2048 * 2048, 2048, 2048, 2048, 1024}; }
    else if (g < TR_E3) { const int q = g - TR_E2, l = q / TR_SQ; tile = q - l * TR_SQ; J = TrJob{P.w_ple_gate + (size_t)l * 2048 * 2048, P.ple_norm + l * 2048, (bf16_t*)(ws + WS_WT_G) + (size_t)l * 2048 * 2048, 2048, 2048, 2048, 0}; }
    else { const int q = g - TR_E3, l = q / TR_PP; tile = q - l * TR_PP; J = TrJob{P.w_ple_proj + (size_t)l * 256 * 2048, nullptr, (bf16_t*)(ws + WS_WT_PP) + (size_t)l * 2048 * 256, 256, 2048, 2048, 0}; }
    return J;
}
__device__ __forceinline__ void transpose_flat(const Params& P, float* lds) {
    const int tid = otid();
    int g = blockIdx.x; if (g >= TR_E4) return;
    int tile; TrJob J = tr_decode(P, g, tile);
    f32x4 v[8]; tr_load(J, tile, tid, v);
    for (;;) {
        const int c4 = (tid & 31) * 4, r0 = tid >> 5;
#pragma unroll
        for (int i = 0; i < 8; ++i) { float* d = lds + (r0 + i * 16) * 129 + c4; d[0] = v[i][0]; d[1] = v[i][1]; d[2] = v[i][2]; d[3] = v[i][3]; }
        __syncthreads();
        const TrJob Jc = J; const int cur = tile; g += gridDim.x; const bool more = g < TR_E4;
        if (more) { J = tr_decode(P, g, tile); tr_load(J, tile, tid, v); }
        const int ntn = Jc.Npad / 128, tk = cur / ntn, tn = cur % ntn, k0 = tk * 128, n0 = tn * 128;
#pragma unroll
        for (int j = 0; j < 4; ++j) { const int c = tid + j * 512, kc = c & 15, n = c >> 4; const float* sp = lds + (kc * 8) * 129 + n;
            u32x4 w; w.x = cvt_pk_bf16(sp[0], sp[129]); w.y = cvt_pk_bf16(sp[2 * 129], sp[3 * 129]); w.z = cvt_pk_bf16(sp[4 * 129], sp[5 * 129]); w.w = cvt_pk_bf16(sp[6 * 129], sp[7 * 129]);
            *(u32x4*)(Jc.Wt + (size_t)(n0 + n) * Jc.K + ((k0 + Jc.krot) % Jc.K) + kc * 8) = w; }
        __syncthreads();
        if (!more) break;
    }
}
__device__ void phase_prep(const Params& P, float* lds) {
    unsigned char* ws = P.ws;
    transpose_flat(P, lds);
    { const size_t n4 = (size_t)DEPTH * T * PLE / 4; const f32x4* src = (const f32x4*)P.p; u32x2* dst = (u32x2*)(ws + WS_PB);
      for (size_t i = (size_t)blockIdx.x * NTHR + otid(); i < n4; i += (size_t)gridDim.x * NTHR) { const f32x4 v = src[i]; u32x2 w; w.x = cvt_pk_bf16(v[0], v[1]); w.y = cvt_pk_bf16(v[2], v[3]); dst[i] = w; } }
    { float* cs = (float*)(ws + WS_COS); float* sn = (float*)(ws + WS_SIN);
      for (int i = blockIdx.x * NTHR + otid(); i < T * 32; i += gridDim.x * NTHR) { const int t = i >> 5, f = i & 31;
          const double inv = exp(-(double)(2 * f) / 64.0 * 9.210340371976184); const double ang = (double)P.positions[t] * inv; cs[i] = (float)cos(ang); sn[i] = (float)sin(ang); } }
}
__device__ void phase_rownorm(const float* __restrict__ src, bf16_t* __restrict__ dst) {
    const int tid = otid(), wid = tid >> 6, lane = tid & 63, stride = gridDim.x * 8;
    int row = blockIdx.x * 8 + wid; f32x4 v[8], nv[8];
    if (row < T) { const f32x4* p = (const f32x4*)(src + (size_t)row * 2048);
#pragma unroll
        for (int j = 0; j < 8; ++j) v[j] = p[lane + 64 * j]; }
    for (; row < T; row += stride) {
        const int rn = row + stride; const bool more = rn < T;
        if (more) { const f32x4* p = (const f32x4*)(src + (size_t)rn * 2048);
#pragma unroll
            for (int j = 0; j < 8; ++j) nv[j] = p[lane + 64 * j]; }
        float ss = 0.f;
#pragma unroll
        for (int j = 0; j < 8; ++j) ss += v[j][0] * v[j][0] + v[j][1] * v[j][1] + v[j][2] * v[j][2] + v[j][3] * v[j][3];
        ss = wave_sum(ss); const float rs = rsqrtf(ss * (1.f / 2048.f) + EPS);
        u32x2* d = (u32x2*)(dst + (size_t)row * 2048);
#pragma unroll
        for (int j = 0; j < 8; ++j) { u32x2 w; w.x = cvt_pk_bf16(v[j][0] * rs, v[j][1] * rs); w.y = cvt_pk_bf16(v[j][2] * rs, v[j][3] * rs); d[lane + 64 * j] = w; }
        if (more) {
#pragma unroll
            for (int j = 0; j < 8; ++j) v[j] = nv[j]; }
    }
}
__device__ void phase_ynorm(bf16_t* __restrict__ Y) {
    const int tid = otid(), wid = tid >> 6, lane = tid & 63;
    for (int row = blockIdx.x * 8 + wid; row < T; row += gridDim.x * 8) {
        u32x4* p = (u32x4*)(Y + (size_t)row * 2048); float f[4][8]; float ss[4];
#pragma unroll
        for (int j = 0; j < 4; ++j) { unpack8(p[lane + 64 * j], f[j]); float s = 0.f;
#pragma unroll
            for (int e = 0; e < 8; ++e) s += f[j][e] * f[j][e];
            ss[j] = s; }
        const float sa = wave_sum(ss[0]), sb = wave_sum(ss[1]), scc = wave_sum(ss[2] + ss[3]);
        float rs[4]; rs[0] = rsqrtf(sa * (1.f / 512.f) + EPS); rs[1] = rsqrtf(sb * (1.f / 512.f) + EPS); rs[2] = rs[3] = rsqrtf(scc * (1.f / 1024.f) + EPS);
#pragma unroll
        for (int j = 0; j < 4; ++j) {
#pragma unroll
            for (int e = 0; e < 8; ++e) f[j][e] *= rs[j];
            p[lane + 64 * j] = pack8(f[j]); }
    }
}
__device__ void phase_knorm(const bf16_t* __restrict__ KV, const float* __restrict__ kn_g, bf16_t* __restrict__ Kb) {
    const int tid = otid(), wid = tid >> 6, lane = tid & 63, h = lane >> 3, sub = lane & 7;
    float g[16];
#pragma unroll
    for (int e = 0; e < 16; ++e) g[e] = kn_g[sub * 16 + e];
    for (int t = blockIdx.x * 8 + wid; t < T; t += gridDim.x * 8) {
        const u32x4* p = (const u32x4*)(KV + (size_t)t * 2048 + h * 256 + sub * 16); float f[16]; unpack8(p[0], f); unpack8(p[1], f + 8);
        float ss = 0.f;
#pragma unroll
        for (int e = 0; e < 16; ++e) ss += f[e] * f[e];
        ss = sum8(ss); const float rs = rsqrtf(ss * (1.f / 128.f) + EPS);
#pragma unroll
        for (int e = 0; e < 16; ++e) f[e] = f[e] * rs * g[e];
        const int b = t / SEQ, s = t % SEQ; u32x4* d = (u32x4*)(Kb + ((size_t)(b * 8 + h) * SEQ + s) * 192 + sub * 16); d[0] = pack8(f); d[1] = pack8(f + 8);
    }
}
__device__ void phase_post_rows(const Params& P, int l) {
    unsigned char* ws = P.ws; const bf16_t* __restrict__ PROJ = (const bf16_t*)(ws + WS_PROJ); bf16_t* __restrict__ Q = (bf16_t*)(ws + WS_Q); bf16_t* __restrict__ Kb = (bf16_t*)(ws + WS_K);
    bf16_t* __restrict__ CK = (bf16_t*)(ws + WS_CKVN); bf16_t* __restrict__ Y = (bf16_t*)(ws + WS_Y); const float* __restrict__ COS = (const float*)(ws + WS_COS); const float* __restrict__ SIN = (const float*)(ws + WS_SIN);
    const int tid = otid(), wid = tid >> 6, lane = tid & 63, h = lane >> 3, sub = lane & 7, ch = lane * 8, fi = (sub & 3) * 8;
    float gqn[16], gqr[8], gkr[8], w0[8], w1[8], w2[8], cb[8];
    { const float* qn_g = P.q_nope_norm + l * 128 + sub * 16; const float* qr_g = P.q_rope_norm + l * 64 + sub * 8; const float* kr_g = P.k_rope_norm + l * 64 + sub * 8;
      const float* cw = P.conv_w + (size_t)l * 3 * 512 + ch; const float* cbias = P.conv_b + (size_t)l * 512 + ch;
#pragma unroll
      for (int e = 0; e < 16; ++e) gqn[e] = qn_g[e];
#pragma unroll
      for (int e = 0; e < 8; ++e) { gqr[e] = qr_g[e]; gkr[e] = kr_g[e]; w0[e] = cw[e]; w1[e] = cw[512 + e]; w2[e] = cw[1024 + e]; cb[e] = cbias[e]; } }
    for (int t = blockIdx.x * 8 + wid; t < T; t += gridDim.x * 8) {
        const int b = t / SEQ, s = t % SEQ; const bf16_t* pr = PROJ + (size_t)t * LDP;
        const size_t qo = ((size_t)(b * 8 + h) * SEQ + s) * 192;
        const bool hasm = s > 0, hasp = s < SEQ - 1; const u32x4 zero4 = {0u, 0u, 0u, 0u};
        const u32x4 lqn0 = *(const u32x4*)(pr + OFF_CQ + 192 * h + sub * 16), lqn1 = *(const u32x4*)(pr + OFF_CQ + 192 * h + sub * 16 + 8);
        const u32x4 lqr = *(const u32x4*)(pr + OFF_CQ + 192 * h + 128 + sub * 8), lkr = *(const u32x4*)(pr + OFF_CKR + sub * 8), lkv = *(const u32x4*)(pr + OFF_CKV + ch);
        const u32x4 lbb = *(const u32x4*)(pr + OFF_BB + ch), lc0 = *(const u32x4*)(pr + OFF_BC + ch), lh0 = *(const u32x4*)(pr + OFF_BH + ch), lzz = *(const u32x4*)(pr + OFF_BZ + ch);
        const u32x4 lcm = hasm ? *(const u32x4*)(pr - LDP + OFF_BC + ch) : zero4, lhm = hasm ? *(const u32x4*)(pr - LDP + OFF_BH + ch) : zero4;
        const u32x4 lcp = hasp ? *(const u32x4*)(pr + LDP + OFF_BC + ch) : zero4, lhp = hasp ? *(const u32x4*)(pr + LDP + OFF_BH + ch) : zero4;
        const f32x4 lc0s = *(const f32x4*)(COS + (size_t)t * 32 + fi), lc1s = *(const f32x4*)(COS + (size_t)t * 32 + fi + 4), ls0s = *(const f32x4*)(SIN + (size_t)t * 32 + fi), ls1s = *(const f32x4*)(SIN + (size_t)t * 32 + fi + 4);
        float cs[8], sn[8];
#pragma unroll
        for (int e = 0; e < 4; ++e) { cs[e] = lc0s[e]; cs[4 + e] = lc1s[e]; sn[e] = ls0s[e]; sn[4 + e] = ls1s[e]; }
        {
            float f[16]; unpack8(lqn0, f); unpack8(lqn1, f + 8);
            float ss = 0.f;
#pragma unroll
            for (int e = 0; e < 16; ++e) ss += f[e] * f[e];
            ss = sum8(ss); const float rs = rsqrtf(ss * (1.f / 128.f) + EPS);
#pragma unroll
            for (int e = 0; e < 16; ++e) f[e] = f[e] * rs * gqn[e];
            u32x4* d = (u32x4*)(Q + qo + sub * 16); d[0] = pack8(f); d[1] = pack8(f + 8);
        }
        {
            float f[8]; unpack8(lqr, f);
            float ss = 0.f;
#pragma unroll
            for (int e = 0; e < 8; ++e) ss += f[e] * f[e];
            ss = sum8(ss); const float rs = rsqrtf(ss * (1.f / 64.f) + EPS); float o8[8];
#pragma unroll
            for (int e = 0; e < 8; ++e) { const float xn = f[e] * rs * gqr[e]; const float pt = __shfl_xor(xn, 4);
                o8[e] = (sub < 4) ? (xn * cs[e] - pt * sn[e]) : (xn * cs[e] + pt * sn[e]); }
            *(u32x4*)(Q + qo + 128 + sub * 8) = pack8(o8);
        }
        {
            float f[8]; unpack8(lkr, f);
            float ss = 0.f;
#pragma unroll
            for (int e = 0; e < 8; ++e) ss += f[e] * f[e];
            ss = sum8(ss); const float rs = rsqrtf(ss * (1.f / 64.f) + EPS); float o8[8];
#pragma unroll
            for (int e = 0; e < 8; ++e) { const float xn = f[e] * rs * gkr[e]; const float pt = __shfl_xor(xn, 4);
                o8[e] = (sub < 4) ? (xn * cs[e] - pt * sn[e]) : (xn * cs[e] + pt * sn[e]); }
            *(u32x4*)(Kb + qo + 128 + sub * 8) = pack8(o8);
        }
        {
            float f[8]; unpack8(lkv, f);
            float ss = 0.f;
#pragma unroll
            for (int e = 0; e < 8; ++e) ss += f[e] * f[e];
            ss = wave_sum(ss); const float rs = rsqrtf(ss * (1.f / 512.f) + EPS);
#pragma unroll
            for (int e = 0; e < 8; ++e) f[e] *= rs;
            *(u32x4*)(CK + (size_t)t * 512 + ch) = pack8(f);
        }
        {
            float bb[8], c0[8], h0[8], zz[8], cm[8], hm[8], cp[8], hp[8];
            unpack8(lbb, bb); unpack8(lc0, c0); unpack8(lh0, h0); unpack8(lzz, zz); unpack8(lcm, cm); unpack8(lhm, hm); unpack8(lcp, cp); unpack8(lhp, hp);
            float o8[8]; float ssb = 0.f;
#pragma unroll
            for (int e = 0; e < 8; ++e) { const float y = cb[e] + w0[e] * (cm[e] * hm[e]) + w1[e] * (c0[e] * h0[e]) + w2[e] * (cp[e] * hp[e]);
                o8[e] = bb[e] * y * silu(zz[e]); ssb += o8[e] * o8[e]; }
            ssb = wave_sum(ssb); const float rsb = rsqrtf(ssb * (1.f / 512.f) + EPS);
#pragma unroll
            for (int e = 0; e < 8; ++e) o8[e] *= rsb;
            *(u32x4*)(Y + (size_t)t * 2048 + YB + ch) = pack8(o8);
        }
    }
}
__device__ void phase_sgu(const Params& P, int l, char* lds) {
    unsigned char* ws = P.ws; const bf16_t* __restrict__ PROJ = (const bf16_t*)(ws + WS_PROJ); bf16_t* __restrict__ Y = (bf16_t*)(ws + WS_Y);
    const int tid = otid(), wid = tid >> 6, lane = tid & 63, fr = lane & 15, fq = lane >> 4;
    constexpr int VST = 264;
    for (int unit = blockIdx.x; unit < (T / 128) * 4; unit += gridDim.x) {
        const int k = unit >> 2, h = unit & 3, t0 = k * 128, n0 = wid * 16, t = t0 + n0 + fr;
        bf16_t r0[16], r1[16];
#pragma unroll
        for (int i = 0; i < 16; ++i) { const bf16_t* pv = PROJ + (size_t)(t0 + wid * 16 + i) * LDP + OFF_AV + h * 128; r0[i] = pv[lane]; r1[i] = pv[lane + 64]; }
        const float* sg = P.sgu_norm + (size_t)(l * 4 + h) * 128; const float g0 = sg[lane], g1 = sg[lane + 64];
        const float* wsp = P.w_spatial + ((size_t)(l * 4 + h) * 128 + n0 + fr) * 128 + fq * 8;
        f32x4 wa[4], wc[4];
#pragma unroll
        for (int kk = 0; kk < 4; ++kk) { wa[kk] = *(const f32x4*)(wsp + kk * 32); wc[kk] = *(const f32x4*)(wsp + kk * 32 + 4); }
        const float bias = P.b_spatial[(size_t)(l * 4 + h) * 128 + n0 + fr]; const bf16_t* pr = PROJ + (size_t)t * LDP + h * 128 + fq * 4;
        u32x2 uw[8], zw[8];
#pragma unroll
        for (int ct = 0; ct < 8; ++ct) { uw[ct] = *(const u32x2*)(pr + OFF_AU + ct * 16); zw[ct] = *(const u32x2*)(pr + OFF_AZ + ct * 16); }
#pragma unroll
        for (int i = 0; i < 16; ++i) { const int m = wid * 16 + i;
            const float x0 = bf2f(r0[i]), x1 = bf2f(r1[i]); const float ss = wave_sum(x0 * x0 + x1 * x1); const float rs = rsqrtf(ss * (1.f / 128.f) + EPS);
            *(bf16_t*)(lds + lane * VST + m * 2) = f2bf(x0 * rs * g0); *(bf16_t*)(lds + (lane + 64) * VST + m * 2) = f2bf(x1 * rs * g1); }
        __syncthreads();
        bf16x8 bw[4];
#pragma unroll
        for (int kk = 0; kk < 4; ++kk) { const f32x4 a = wa[kk], c = wc[kk];
            u32x4 w; w.x = cvt_pk_bf16(a[0], a[1]); w.y = cvt_pk_bf16(a[2], a[3]); w.z = cvt_pk_bf16(c[0], c[1]); w.w = cvt_pk_bf16(c[2], c[3]); bw[kk] = *reinterpret_cast<bf16x8*>(&w); }
        f32x4 acc[8];
#pragma unroll
        for (int ct = 0; ct < 8; ++ct) { acc[ct] = (f32x4){0.f, 0.f, 0.f, 0.f};
#pragma unroll
            for (int kk = 0; kk < 4; ++kk) { const char* ap = lds + (ct * 16 + fr) * VST + (kk * 32 + fq * 8) * 2;
                const u32x2 lo = *(const u32x2*)ap, hi2 = *(const u32x2*)(ap + 8); u32x4 w = {lo.x, lo.y, hi2.x, hi2.y};
                acc[ct] = __builtin_amdgcn_mfma_f32_16x16x32_bf16(*reinterpret_cast<bf16x8*>(&w), bw[kk], acc[ct], 0, 0, 0); } }
        float ssa = 0.f;
#pragma unroll
        for (int ct = 0; ct < 8; ++ct) {
            const float v0 = bflo(uw[ct].x) * (acc[ct][0] + bias) * silu(bflo(zw[ct].x)), v1 = bfhi(uw[ct].x) * (acc[ct][1] + bias) * silu(bfhi(zw[ct].x));
            const float v2 = bflo(uw[ct].y) * (acc[ct][2] + bias) * silu(bflo(zw[ct].y)), v3 = bfhi(uw[ct].y) * (acc[ct][3] + bias) * silu(bfhi(zw[ct].y));
            ssa += (v0 * v0 + v1 * v1) + (v2 * v2 + v3 * v3);
            u32x2 w; w.x = cvt_pk_bf16(v0, v1); w.y = cvt_pk_bf16(v2, v3); *(u32x2*)(Y + (size_t)t * 2048 + YA + h * 128 + ct * 16 + fq * 4) = w; }
        ssa += __shfl_xor(ssa, 16); ssa += __shfl_xor(ssa, 32);
        if (fq == 0) ((float*)(ws + WS_SSQA))[(size_t)t * 4 + h] = ssa;
        __syncthreads();
    }
}
__device__ void phase_attn(const Params& P, char* lds) {
    unsigned char* ws = P.ws; const bf16_t* Q = (const bf16_t*)(ws + WS_Q); const bf16_t* Kb = (const bf16_t*)(ws + WS_K); const bf16_t* KV = (const bf16_t*)(ws + WS_KV);
    const bf16_t* PROJ = (const bf16_t*)(ws + WS_PROJ); bf16_t* Y = (bf16_t*)(ws + WS_Y);
    for (int v = blockIdx.x; v < BATCH * 8 * (SEQ / 256); v += gridDim.x) {
        const int h = v & 7, qb = (v >> 3) & 31, b = v >> 8; const size_t tq = (size_t)b * SEQ + qb * 256;
        att::attn_body(Q + ((size_t)(b * 8 + h) * SEQ + qb * 256) * 192, Kb + (size_t)(b * 8 + h) * SEQ * 192, KV + (size_t)b * SEQ * 2048 + h * 256 + 128,
                       PROJ + tq * LDP + OFF_CZ + h * 128, Y + tq * 2048 + YC + h * 128, (float*)(ws + WS_SSQC) + tq * 8 + h, SEQ, lds);
    }
}

constexpr int LDS_BYTES = pg8::STAGE_BYTES + 16 + 4096;
static_assert(att::SHM_ATTN <= pg8::STAGE_BYTES, "attention LDS");
__global__ void __launch_bounds__(NTHR, 2) fwd_megakernel(Params P) {
    extern __shared__ __attribute__((aligned(16))) unsigned char lds[];
    cg::grid_group grid = cg::this_grid();
    unsigned char* ws = P.ws; const int G = gridDim.x;
    bf16_t* HN = (bf16_t*)(ws + WS_Y); bf16_t* Y = (bf16_t*)(ws + WS_Y); bf16_t* PROJ = (bf16_t*)(ws + WS_PROJ); bf16_t* PPb = (bf16_t*)(ws + WS_PP);
    bf16_t* CK = (bf16_t*)(ws + WS_CKVN); bf16_t* KV = (bf16_t*)(ws + WS_KV); bf16_t* Kb = (bf16_t*)(ws + WS_K);
    PG8_LAS unsigned char* llds = (PG8_LAS unsigned char*)lds;
    volatile PG8_LAS unsigned* bst = (volatile PG8_LAS unsigned*)(llds + pg8::STAGE_BYTES);
    if (threadIdx.x < 4) bst[threadIdx.x] = 0u;
    __syncthreads();
    XcdBarrier xb = xcd_barrier_post((unsigned*)(ws + WS_BAR), bst);
#define GSYNC() xcd_barrier(xb)

    phase_prep(P, (float*)lds);
    grid.sync();
    for (int l = 0; l < DEPTH; ++l) {
        const float* hin = (l == 0) ? P.x : P.out;
        phase_rownorm(hin, HN);
        GSYNC();
        { pg8::Gemm g{HN, (const bf16_t*)(ws + WS_WT_IN) + (size_t)l * LDP * 2048, T, LDP, 2048}; pg8::StaticOrder S; S.init(T, LDP, G, (int)blockIdx.x);
          pg8::EpiBf16Store E{PROJ, LDP}; pg8::gemm_phase(llds, g, S, E); }
        GSYNC();
        phase_sgu(P, l, (char*)lds);
        phase_post_rows(P, l);
        GSYNC();
        { pg8::Gemm g{CK, (const bf16_t*)(ws + WS_WT_UKV) + (size_t)l * 2048 * 512, T, 2048, 512}; pg8::StaticOrder S; S.init(T, 2048, G, (int)blockIdx.x);
          pg8::EpiKV E{Kb, KV, P.k_nope_norm + l * 128, (PG8_LAS float*)(llds + LDS_BYTES - 4096)}; pg8::gemm_phase(llds, g, S, E); }
        { pg8::Gemm g{(const bf16_t*)(ws + WS_PB) + (size_t)l * T * 256, (const bf16_t*)(ws + WS_WT_PP) + (size_t)l * 2048 * 256, T, 2048, 256}; pg8::StaticOrder S; S.init(T, 2048, G, (int)blockIdx.x);
          pg8::EpiBf16Store E{PPb, 2048}; pg8::gemm_phase(llds, g, S, E); }
        GSYNC();
        phase_attn(P, (char*)lds);
        GSYNC();
        { pg8::Gemm g{Y, (const bf16_t*)(ws + WS_WT_OUT) + (size_t)l * 2048 * 2048, T, 2048, 2048}; pg8::StaticOrder S; S.init(T, 2048, G, (int)blockIdx.x);
          pg8::EpiResMid E{hin, P.out, (const float*)(ws + WS_SSQA), (const float*)(ws + WS_SSQC), (bf16_t*)(ws + WS_KV), (float*)(ws + WS_SSQ2)};   pg8::gemm_phase(llds, g, S, E); }
        GSYNC();
        { pg8::Gemm g{(const bf16_t*)(ws + WS_KV), (const bf16_t*)(ws + WS_WT_G) + (size_t)l * 2048 * 2048, T, 2048, 2048}; pg8::StaticOrder S; S.init(T, 2048, G, (int)blockIdx.x);
          pg8::EpiGate E{P.out, PPb, (const float*)(ws + WS_SSQ2)}; pg8::gemm_phase(llds, g, S, E); }
        if (l + 1 < DEPTH) GSYNC();
    }
}

extern "C" void kernel_launch(void* const* d_in, const int* in_sizes, int n_in, void* d_out, int out_size, void* d_ws, size_t ws_size, hipStream_t stream) {
    static int grid_blocks = 0;
    if (grid_blocks == 0) {
        if (n_in != 21 || out_size != T * D_MODEL || ws_size < WS_END) { fprintf(stderr, "kernel_launch: unexpected shapes (n_in %d, out %d, ws %zu need %zu)\n", n_in, out_size, ws_size, (size_t)WS_END); grid_blocks = -1; return; }
        int dev = 0, cus = 0, per_cu = 0;
        hipGetDevice(&dev); hipDeviceGetAttribute(&cus, hipDeviceAttributeMultiprocessorCount, dev);
        if (hipFuncSetAttribute((const void*)fwd_megakernel, hipFuncAttributeMaxDynamicSharedMemorySize, LDS_BYTES) != hipSuccess) { fprintf(stderr, "kernel_launch: hipFuncSetAttribute failed\n"); grid_blocks = -1; return; }
        hipOccupancyMaxActiveBlocksPerMultiprocessor(&per_cu, (const void*)fwd_megakernel, NTHR, LDS_BYTES);
        if (per_cu < 1) { fprintf(stderr, "kernel_launch: occupancy query says %d blocks per CU\n", per_cu); per_cu = 1; }
        if (per_cu > 1) per_cu = 1;
        grid_blocks = cus * per_cu;
    }
    if (grid_blocks < 0) return;
    Params P{};
    P.x = (const float*)d_in[0]; P.p = (const float*)d_in[1]; P.positions = (const int*)d_in[2]; P.attn_norm = (const float*)d_in[3]; P.w_in = (const float*)d_in[4];
    P.sgu_norm = (const float*)d_in[5]; P.w_spatial = (const float*)d_in[6]; P.b_spatial = (const float*)d_in[7]; P.conv_w = (const float*)d_in[8]; P.conv_b = (const float*)d_in[9];
    P.kv_norm = (const float*)d_in[10]; P.w_ukv = (const float*)d_in[11]; P.q_nope_norm = (const float*)d_in[12]; P.q_rope_norm = (const float*)d_in[13];
    P.k_nope_norm = (const float*)d_in[14]; P.k_rope_norm = (const float*)d_in[15]; P.out_norm = (const float*)d_in[16]; P.w_out = (const float*)d_in[17];
    P.ple_norm = (const float*)d_in[18]; P.w_ple_gate = (const float*)d_in[19]; P.w_ple_proj = (const float*)d_in[20]; P.out = (float*)d_out; P.ws = (unsigned char*)d_ws;
    if (hipMemsetAsync((unsigned char*)d_ws + WS_BAR, 0, 16384, stream) != hipSuccess) { fprintf(stderr, "kernel_launch: memset failed\n"); return; }
    void* args[] = {&P};
    hipError_t e = hipLaunchCooperativeKernel((const void*)fwd_megakernel, dim3(grid_blocks), dim3(NTHR), args, LDS_BYTES, stream);
    if (e != hipSuccess) fprintf(stderr, "kernel_launch: cooperative launch failed: %s (grid %d)\n", hipGetErrorString(e), grid_blocks);
}
```

```cpp
#include <hip/hip_runtime.h>
#include <hip/hip_cooperative_groups.h>
#include <cstdio>
#include <cstdint>
namespace cg = cooperative_groups;

constexpr int D_MODEL = 2048, BATCH = 2, SEQ = 8192, DEPTH = 4, T = BATCH * SEQ;
constexpr int PLE = 256, IN_W = 6720, LDP = 6912  ;
constexpr int OFF_AU = 0, OFF_AV = 512, OFF_AZ = 1024, OFF_BB = 1536, OFF_BC = 2048, OFF_BH = 2560, OFF_BZ = 3072,
              OFF_CQ = 3584, OFF_CKV = 5120, OFF_CKR = 5632, OFF_CZ = 5696;
constexpr float EPS = 1e-6f;
constexpr int NTHR = 512;
constexpr int YC = 0, YA = 1024, YB = 1536;

typedef unsigned short bf16_t;
typedef short bf16x8 __attribute__((ext_vector_type(8)));
typedef short s16x4 __attribute__((ext_vector_type(4)));
typedef float f32x4 __attribute__((ext_vector_type(4)));
typedef float f32x16 __attribute__((ext_vector_type(16)));
typedef unsigned u32x4 __attribute__((ext_vector_type(4)));
typedef unsigned u32x2 __attribute__((ext_vector_type(2)));

constexpr size_t SZ_WT_IN = (size_t)DEPTH * LDP * 2048 * 2, SZ_WT_UKV = (size_t)DEPTH * 2048 * 512 * 2, SZ_WT_SQ = (size_t)DEPTH * 2048 * 2048 * 2,
                 SZ_WT_PP = (size_t)DEPTH * 2048 * 256 * 2, SZ_PB = (size_t)DEPTH * T * 256 * 2, SZ_ACT = (size_t)T * 2048 * 2,
                 SZ_PROJ = (size_t)T * LDP * 2, SZ_CKVN = (size_t)T * 512 * 2, SZ_QK = (size_t)BATCH * 8 * SEQ * 192 * 2, SZ_ROPE = (size_t)T * 32 * 4;
constexpr size_t WS_WT_IN = 0, WS_WT_UKV = WS_WT_IN + SZ_WT_IN, WS_WT_OUT = WS_WT_UKV + SZ_WT_UKV, WS_WT_G = WS_WT_OUT + SZ_WT_SQ,
                 WS_WT_PP = WS_WT_G + SZ_WT_SQ, WS_PB = WS_WT_PP + SZ_WT_PP, WS_Y = WS_PB + SZ_PB  , WS_PROJ = WS_Y + SZ_ACT,
                 WS_PP = WS_PROJ + SZ_PROJ, WS_CKVN = WS_PP + SZ_ACT, WS_KV = WS_CKVN + SZ_CKVN, WS_Q = WS_KV + SZ_ACT, WS_K = WS_Q + SZ_QK,
                 WS_COS = WS_K + SZ_QK, WS_SIN = WS_COS + SZ_ROPE, WS_BAR = WS_SIN + SZ_ROPE, WS_SSQA = WS_BAR + 16384, WS_SSQC = WS_SSQA + (size_t)T * 4 * 4, WS_SSQ2 = WS_SSQC + (size_t)T * 8 * 4, WS_END = WS_SSQ2 + (size_t)T * 32 * 4;

struct Params {
    const float* x; const float* p; const int* positions; const float* attn_norm; const float* w_in; const float* sgu_norm; const float* w_spatial;
    const float* b_spatial; const float* conv_w; const float* conv_b; const float* kv_norm; const float* w_ukv; const float* q_nope_norm;
    const float* q_rope_norm; const float* k_nope_norm; const float* k_rope_norm; const float* out_norm; const float* w_out; const float* ple_norm;
    const float* w_ple_gate; const float* w_ple_proj; float* out; unsigned char* ws;
};

typedef const __attribute__((address_space(4))) Params* KPtr;
__device__ __forceinline__ KPtr kp_fresh() { KPtr k = (KPtr)__builtin_amdgcn_kernarg_segment_ptr(); asm volatile("" : "+s"(k)); return k; }
__device__ __forceinline__ int otid(int wv) { unsigned z = 0u; asm volatile("" : "+v"(z)); return (int)__builtin_amdgcn_mbcnt_hi(~0u, __builtin_amdgcn_mbcnt_lo(~0u, z)) + 64 * wv; }
__device__ __forceinline__ float bf2f(bf16_t u) { return __uint_as_float(((unsigned)u) << 16); }
__device__ __forceinline__ float bflo(unsigned w) { return __uint_as_float(w << 16); }
__device__ __forceinline__ float bfhi(unsigned w) { return __uint_as_float(w & 0xffff0000u); }
__device__ __forceinline__ unsigned cvt_pk_bf16(float lo, float hi) { unsigned r; asm volatile("v_cvt_pk_bf16_f32 %0, %1, %2" : "=v"(r) : "v"(lo), "v"(hi)); return r; }
__device__ __forceinline__ bf16_t f2bf(float f) { return (bf16_t)(cvt_pk_bf16(f, 0.f) & 0xffffu); }
__device__ __forceinline__ float wave_sum(float v) { v += __shfl_xor(v, 32); v += __shfl_xor(v, 16); v += __shfl_xor(v, 8); v += __shfl_xor(v, 4); v += __shfl_xor(v, 2); v += __shfl_xor(v, 1); return v; }
__device__ __forceinline__ float sum8(float v) { v += __shfl_xor(v, 4); v += __shfl_xor(v, 2); v += __shfl_xor(v, 1); return v; }
__device__ __forceinline__ float silu(float z) { return z / (1.f + __expf(-z)); }
__device__ __forceinline__ float sigmoidf(float z) { return 1.f / (1.f + __expf(-z)); }
__device__ __forceinline__ void unpack8(u32x4 w, float* f) { f[0] = bflo(w.x); f[1] = bfhi(w.x); f[2] = bflo(w.y); f[3] = bfhi(w.y); f[4] = bflo(w.z); f[5] = bfhi(w.z); f[6] = bflo(w.w); f[7] = bfhi(w.w); }
__device__ __forceinline__ u32x4 pack8(const float* f) { u32x4 w; w.x = cvt_pk_bf16(f[0], f[1]); w.y = cvt_pk_bf16(f[2], f[3]); w.z = cvt_pk_bf16(f[4], f[5]); w.w = cvt_pk_bf16(f[6], f[7]); return w; }

namespace pg8 {
#define PG8_LAS __attribute__((address_space(3)))
constexpr int BM = 256, BK = 64, HALF = 128, HTB = HALF * BK * 2, STAGE_BYTES = 8 * HTB, NXCD = 8, WGM = 8;
__host__ __device__ __forceinline__ int lds_byte(int r, int c) { const int st = (r >> 4) * 2 + (c >> 5), rr = r & 15, cc = c & 31, ob = rr * 64 + cc * 2; return st * 1024 + (ob ^ (((ob >> 9) & 1) << 5)); }
__host__ __device__ __forceinline__ void stage_rc(int b, int& R, int& C) { const int st = b / 1024, sb = b % 1024, swz = sb ^ (((sb >> 9) & 1) << 5); R = (st >> 1) * 16 + swz / 64; C = (st & 1) * 32 + (swz % 64) / 2; }
__host__ __device__ __forceinline__ int perm32(int rho) { const int n = rho >> 4, i = rho & 15; return 8 * (i >> 2) + 4 * n + (i & 3); }
struct Unit { int pm, pn; };
struct Gemm { const bf16_t* A; const bf16_t* Bt; int M, N, K; };
struct StaticOrder {
    int nM, nN, nwg, G, c;
    __device__ void init(int M, int N, int G_, int c_) { nM = M / BM; nN = N / BM; nwg = nM * nN; G = G_; c = c_; }
    __device__ bool next(int i, Unit& u) const {
        const long L = (long)i * G + c; if (L >= nwg) return false;
        int wgid = (int)L; { const int q = nwg / NXCD, r = nwg % NXCD, xcd = wgid % NXCD, off = wgid / NXCD; wgid = (xcd < r ? xcd * (q + 1) : r * (q + 1) + (xcd - r) * q) + off; }
        const int nig = WGM * nN, gid = wgid / nig, fm = gid * WGM, gsz = (nM - fm) < WGM ? (nM - fm) : WGM;
        u.pm = fm + ((wgid % nig) % gsz); u.pn = (wgid % nig) / gsz; return true;
    }
};
template <class Epi>
__device__ __forceinline__ void gemm_phase(PG8_LAS unsigned char* lds, const Gemm g, const StaticOrder& S, const Epi& E, int wv) {
    const int tid = otid(wv), wid = __builtin_amdgcn_readfirstlane(tid >> 6), lane = tid & 63, wr = wid >> 2, wc = wid & 3, fr = lane & 15, fq = lane >> 4;
    const int K = g.K, nt = K / BK;
    unsigned voffA[2], voffB[2];
#pragma unroll
    for (int i = 0; i < 2; ++i) { int R, C; stage_rc(tid * 16 + i * 8192, R, C); const int Rb = Epi::PERM ? ((R & ~31) + perm32(R & 31)) : R;
        voffA[i] = (unsigned)(R * K + C) * 2u; voffB[i] = (unsigned)(Rb * K + C) * 2u; }
    const size_t kstep = (size_t)(BK * 2);
    const size_t hstep = (size_t)HALF * K * 2;
    const size_t tstep = 2 * hstep;
    const unsigned ldsw = (unsigned)wid * 1024u;
    const int aoff = lds_byte(wr * 64 + fr, fq * 8), boff = lds_byte(wc * 32 + fr, fq * 8);
#define PG8_SA(b, h) (((b) * 2 + (h)) * HTB)
#define PG8_SB(b, h) ((4 + (b) * 2 + (h)) * HTB)
#define PG8_STAGE(bufoff, gbase, voff) do { _Pragma("unroll") for (int _i = 0; _i < 2; ++_i) \
        __builtin_amdgcn_global_load_lds((const unsigned*)((const char*)(gbase) + (voff)[_i]), (PG8_LAS unsigned*)(lds + (bufoff) + ldsw + _i * 8192), 16, 0, 0); } while (0)
#define PG8_LDA(dst, b, h) do { _Pragma("unroll") for (int m = 0; m < 4; ++m) _Pragma("unroll") for (int k = 0; k < 2; ++k) dst[m][k] = *(const PG8_LAS bf16x8*)(lds + PG8_SA(b, h) + aoff + m * 2048 + k * 1024); } while (0)
#define PG8_LDB(dst, b, h) do { _Pragma("unroll") for (int n = 0; n < 2; ++n) _Pragma("unroll") for (int k = 0; k < 2; ++k) dst[n][k] = *(const PG8_LAS bf16x8*)(lds + PG8_SB(b, h) + boff + n * 2048 + k * 1024); } while (0)
#define PG8_MMA(ai, bj, At, Bt) do { __builtin_amdgcn_s_setprio(1); _Pragma("unroll") for (int m = 0; m < 4; ++m) _Pragma("unroll") for (int n = 0; n < 2; ++n) _Pragma("unroll") for (int k = 0; k < 2; ++k) \
        acc[ai][bj][m][n] = __builtin_amdgcn_mfma_f32_16x16x32_bf16(Bt[n][k], At[m][k], acc[ai][bj][m][n], 0, 0, 0); __builtin_amdgcn_s_setprio(0); } while (0)
#define PG8_WAIT_V(n) asm volatile("s_waitcnt vmcnt(" #n ")" ::: "memory")
#define PG8_WAIT_L(n) asm volatile("s_waitcnt lgkmcnt(" #n ")" ::: "memory")
#define PG8_BAR __builtin_amdgcn_s_barrier()
#define PG8_SCHED __builtin_amdgcn_sched_barrier(0)
    Unit cur, nxt; int ui = 0;
    if (!S.next(0, cur)) return;
    f32x4 acc[2][2][4][2];
#pragma unroll
    for (int a = 0; a < 2; ++a)
#pragma unroll
        for (int b = 0; b < 2; ++b)
#pragma unroll
            for (int m = 0; m < 4; ++m)
#pragma unroll
                for (int n = 0; n < 2; ++n) acc[a][b][m][n] = (f32x4){0.f, 0.f, 0.f, 0.f};
    bf16x8 At[4][2], B0[2][2], B1[2][2];
    float hk[8];
    const char* cA = (const char*)g.A + (size_t)cur.pm * tstep; const char* cB = (const char*)g.Bt + (size_t)cur.pn * tstep;
    PG8_STAGE(PG8_SB(0, 0), cB, voffB); PG8_STAGE(PG8_SA(0, 0), cA, voffA); PG8_STAGE(PG8_SB(0, 1), cB + hstep, voffB); PG8_STAGE(PG8_SA(0, 1), cA + hstep, voffA);
    if (wr == 1) PG8_BAR;
    PG8_WAIT_V(4); PG8_BAR;
    PG8_STAGE(PG8_SB(1, 0), cB + kstep, voffB); PG8_STAGE(PG8_SA(1, 0), cA + kstep, voffA); PG8_STAGE(PG8_SB(1, 1), cB + hstep + kstep, voffB);
    PG8_WAIT_V(6); PG8_BAR;
    for (;;) {
        const bool has_next = S.next(ui + 1, nxt);
        const char* nA = has_next ? (const char*)g.A + (size_t)nxt.pm * tstep : cA; const char* nB = has_next ? (const char*)g.Bt + (size_t)nxt.pn * tstep : cB;
        constexpr int NSEG = Epi::HOOKS ? 3 : 1;
#pragma unroll
        for (int seg = 0; seg < NSEG; ++seg) {
        int tb = 0, te = nt;
        if constexpr (Epi::HOOKS) { tb = (seg == 0) ? 0 : (seg == 1 ? Epi::T1 : Epi::T2); te = (seg == 0) ? Epi::T1 : (seg == 1 ? Epi::T2 : nt);
            if (seg == 1) { PG8_SCHED; E.hook1(acc, hk, cur, wr, lane); PG8_SCHED; } if (seg == 2) { PG8_SCHED; E.hook2(acc, hk); PG8_SCHED; } }
        for (int t = tb; t < te; t += 2) {
            const bool last = (t == nt - 2);
            const char* a1 = cA + (size_t)(t + 1) * kstep;
            const char* a2 = last ? nA : cA + (size_t)(t + 2) * kstep; const char* b2 = last ? nB : cB + (size_t)(t + 2) * kstep;
            const char* a3 = a2 + kstep; const char* b3 = b2 + kstep;
            PG8_LDB(B0, 0, 0); PG8_SCHED; PG8_LDA(At, 0, 0); PG8_STAGE(PG8_SA(1, 1), a1 + hstep, voffA);
            PG8_WAIT_L(8); PG8_BAR; PG8_WAIT_L(0); PG8_MMA(0, 0, At, B0); PG8_BAR; PG8_SCHED;
            PG8_LDB(B1, 0, 1); PG8_STAGE(PG8_SB(0, 0), b2, voffB);
            PG8_BAR; PG8_WAIT_L(0); PG8_MMA(0, 1, At, B1); PG8_BAR;
            PG8_LDA(At, 0, 1); PG8_STAGE(PG8_SA(0, 0), a2, voffA);
            PG8_BAR; PG8_WAIT_L(0); PG8_MMA(1, 0, At, B0); PG8_BAR; PG8_SCHED;
            PG8_STAGE(PG8_SB(0, 1), b2 + hstep, voffB);
            PG8_WAIT_V(6); PG8_BAR; PG8_MMA(1, 1, At, B1); PG8_BAR;
            PG8_LDB(B0, 1, 0); PG8_SCHED; PG8_LDA(At, 1, 0); PG8_STAGE(PG8_SA(0, 1), a2 + hstep, voffA);
            PG8_WAIT_L(8); PG8_BAR; PG8_WAIT_L(0); PG8_MMA(0, 0, At, B0); PG8_BAR; PG8_SCHED;
            PG8_LDB(B1, 1, 1); PG8_STAGE(PG8_SB(1, 0), b3, voffB);
            PG8_BAR; PG8_WAIT_L(0); PG8_MMA(0, 1, At, B1); PG8_BAR;
            PG8_LDA(At, 1, 1); PG8_STAGE(PG8_SA(1, 0), a3, voffA);
            PG8_BAR; PG8_WAIT_L(0); PG8_MMA(1, 0, At, B0); PG8_BAR; PG8_SCHED;
            PG8_STAGE(PG8_SB(1, 1), b3 + hstep, voffB);
            PG8_WAIT_V(6); PG8_BAR; PG8_MMA(1, 1, At, B1); PG8_BAR;
        }
        }
        E(acc, cur, wr, wc, fr, fq);
        if (!has_next) break;
#pragma unroll
        for (int a = 0; a < 2; ++a)
#pragma unroll
            for (int b = 0; b < 2; ++b)
#pragma unroll
                for (int m = 0; m < 4; ++m)
#pragma unroll
                    for (int n = 0; n < 2; ++n) acc[a][b][m][n] = (f32x4){0.f, 0.f, 0.f, 0.f};
        cur = nxt; cA = nA; cB = nB; ++ui;
    }
    PG8_WAIT_V(0);
    if (wr == 0) PG8_BAR;
    PG8_BAR;
#undef PG8_SA
#undef PG8_SB
#undef PG8_STAGE
#undef PG8_LDA
#undef PG8_LDB
#undef PG8_MMA
#undef PG8_WAIT_V
#undef PG8_WAIT_L
#undef PG8_BAR
#undef PG8_SCHED
}

struct EpiBf16Store {
    static constexpr bool PERM = true; static constexpr bool HOOKS = false;
    bf16_t* O; int ldc;
    __device__ __forceinline__ void operator()(const f32x4 (&acc)[2][2][4][2], const Unit& u, int wr, int wc, int fr, int fq) const {
        const int row0 = u.pm * BM + wr * 64 + fr, col0 = u.pn * BM + wc * 32 + 8 * fq;
#pragma unroll
        for (int ai = 0; ai < 2; ++ai)
#pragma unroll
            for (int m = 0; m < 4; ++m) { bf16_t* rowp = O + (size_t)(row0 + ai * HALF + m * 16) * ldc + col0;
#pragma unroll
                for (int bj = 0; bj < 2; ++bj) { const f32x4 v0 = acc[ai][bj][m][0], v1 = acc[ai][bj][m][1];
                    u32x4 w; w.x = cvt_pk_bf16(v0[0], v0[1]); w.y = cvt_pk_bf16(v0[2], v0[3]); w.z = cvt_pk_bf16(v1[0], v1[1]); w.w = cvt_pk_bf16(v1[2], v1[3]);
                    *(u32x4*)(rowp + bj * HALF) = w; } }
    }
};
struct EpiResF32 {
    static constexpr bool PERM = false; static constexpr bool HOOKS = false;
    const float* in; float* out;
    __device__ __forceinline__ void operator()(const f32x4 (&acc)[2][2][4][2], const Unit& u, int wr, int wc, int fr, int fq) const {
        const int row0 = u.pm * BM + wr * 64 + fr, col0 = u.pn * BM + wc * 32 + 4 * fq;
#pragma unroll
        for (int ai = 0; ai < 2; ++ai)
#pragma unroll
            for (int m = 0; m < 4; ++m) { const size_t ro = (size_t)(row0 + ai * HALF + m * 16) * D_MODEL + col0;
#pragma unroll
                for (int bj = 0; bj < 2; ++bj)
#pragma unroll
                    for (int n = 0; n < 2; ++n) { const f32x4 r = *(const f32x4*)(in + ro + bj * HALF + n * 16); *(f32x4*)(out + ro + bj * HALF + n * 16) = r + acc[ai][bj][m][n]; } }
    }
};
struct EpiGate {
    static constexpr bool PERM = false; static constexpr bool HOOKS = false;
    float* h; const bf16_t* pp; const float* ssq_in;
    __device__ __forceinline__ void operator()(const f32x4 (&acc)[2][2][4][2], const Unit& u, int wr, int wc, int fr, int fq) const {
        int lx = fr | (fq << 4); asm volatile("" : "+v"(lx));
        const int frx = lx & 15, fqx = lx >> 4;
        const int row0 = u.pm * BM + wr * 64 + frx, col0 = u.pn * BM + wc * 32 + 4 * fqx;
#pragma unroll
        for (int ai = 0; ai < 2; ++ai) {
            float rs[4];
#pragma unroll
            for (int m = 0; m < 4; ++m) { const float* sp = ssq_in + ((row0 + ai * HALF + m * 16) * 32 + fqx * 8); const f32x4 a = *(const f32x4*)sp, b = *(const f32x4*)(sp + 4);
                float t = ((a[0] + a[1]) + (a[2] + a[3])) + ((b[0] + b[1]) + (b[2] + b[3])); t += __shfl_xor(t, 16); t += __shfl_xor(t, 32); rs[m] = rsqrtf(t * (1.f / 2048.f) + EPS); }
#pragma unroll
            for (int m = 0; m < 4; ++m) { const size_t ro = (size_t)(row0 + ai * HALF + m * 16) * D_MODEL + col0; const float rr = rs[m];
#pragma unroll
                for (int bj = 0; bj < 2; ++bj)
#pragma unroll
                    for (int n = 0; n < 2; ++n) { const size_t o = ro + bj * HALF + n * 16; const f32x4 r = *(const f32x4*)(h + o); const u32x2 pw = *(const u32x2*)(pp + o);
                        const f32x4 a = acc[ai][bj][m][n] * rr; f32x4 v;
                        v[0] = r[0] + sigmoidf(a[0]) * bflo(pw.x); v[1] = r[1] + sigmoidf(a[1]) * bfhi(pw.x); v[2] = r[2] + sigmoidf(a[2]) * bflo(pw.y); v[3] = r[3] + sigmoidf(a[3]) * bfhi(pw.y);
                        *(f32x4*)(h + o) = v; } } }
    }
};
struct EpiKV {
    static constexpr bool PERM = true; static constexpr bool HOOKS = false;
    bf16_t* Kb; bf16_t* KV; const float* kn_g; PG8_LAS float* xl;
    __device__ __forceinline__ void operator()(const f32x4 (&acc)[2][2][4][2], const Unit& u, int wr, int wc, int fr, int fq) const {
        const int rl0 = wr * 64 + fr, c0 = wc * 32 + 8 * fq, h = u.pn;
#pragma unroll
        for (int ai = 0; ai < 2; ++ai)
#pragma unroll
            for (int m = 0; m < 4; ++m) { const f32x4 a = acc[ai][0][m][0], b = acc[ai][0][m][1];
                float s = (a[0] * a[0] + a[1] * a[1]) + (a[2] * a[2] + a[3] * a[3]) + (b[0] * b[0] + b[1] * b[1]) + (b[2] * b[2] + b[3] * b[3]);
                s += __shfl_xor(s, 16); s += __shfl_xor(s, 32);
                if (fq == 0) xl[(ai * HALF + rl0 + m * 16) * 4 + wc] = s; }
        asm volatile("s_waitcnt lgkmcnt(0)" ::: "memory"); __builtin_amdgcn_s_barrier(); asm volatile("" ::: "memory");
        float g[8];
        { const f32x4 g0 = *(const f32x4*)(kn_g + c0), g1 = *(const f32x4*)(kn_g + c0 + 4);
#pragma unroll
          for (int j = 0; j < 4; ++j) { g[j] = g0[j]; g[4 + j] = g1[j]; } }
#pragma unroll
        for (int ai = 0; ai < 2; ++ai)
#pragma unroll
            for (int m = 0; m < 4; ++m) { const int rl = ai * HALF + rl0 + m * 16; const f32x4 p = *(const PG8_LAS f32x4*)(xl + rl * 4);
                const float rs = rsqrtf(((p[0] + p[1]) + (p[2] + p[3])) * (1.f / 128.f) + EPS);
                const int t = u.pm * BM + rl, b = t / SEQ, sq = t - b * SEQ;
                const f32x4 k0 = acc[ai][0][m][0] * rs, k1 = acc[ai][0][m][1] * rs, v0 = acc[ai][1][m][0], v1 = acc[ai][1][m][1];
                u32x4 w; w.x = cvt_pk_bf16(k0[0] * g[0], k0[1] * g[1]); w.y = cvt_pk_bf16(k0[2] * g[2], k0[3] * g[3]); w.z = cvt_pk_bf16(k1[0] * g[4], k1[1] * g[5]); w.w = cvt_pk_bf16(k1[2] * g[6], k1[3] * g[7]);
                *(u32x4*)(Kb + ((size_t)(b * 8 + h) * SEQ + sq) * 192 + c0) = w;
                u32x4 x; x.x = cvt_pk_bf16(v0[0], v0[1]); x.y = cvt_pk_bf16(v0[2], v0[3]); x.z = cvt_pk_bf16(v1[0], v1[1]); x.w = cvt_pk_bf16(v1[2], v1[3]);
                *(u32x4*)(KV + (size_t)t * 2048 + h * 256 + 128 + c0) = x; }
    }
};
struct EpiResMid {
    static constexpr bool PERM = false; static constexpr bool HOOKS = true; static constexpr int T1 = 16, T2 = 24;
    const float* in; float* out; const float* ssqa; const float* ssqc;
    bf16_t* hb; float* ssq2;
    __device__ __forceinline__ void hook1(f32x4 (&acc)[2][2][4][2], float (&hk)[8], const Unit& u, int wr, int fr) const {
        int frx = fr; asm volatile("" : "+v"(frx));
        const int row0 = u.pm * BM + wr * 64 + (frx & 15), fq = (frx >> 4) & 3;
        typedef float f32x2 __attribute__((ext_vector_type(2)));
#pragma unroll
        for (int ai = 0; ai < 2; ++ai) {
            float cs[4], as_[4];
#pragma unroll
            for (int m = 0; m < 4; ++m) { const int row = row0 + ai * HALF + m * 16; const f32x2 c = *(const f32x2*)(ssqc + (row * 8 + fq * 2)); cs[m] = c.x + c.y; as_[m] = ssqa[row * 4 + fq]; }
#pragma unroll
            for (int m = 0; m < 4; ++m) { cs[m] += __shfl_xor(cs[m], 16); cs[m] += __shfl_xor(cs[m], 32); as_[m] += __shfl_xor(as_[m], 16); as_[m] += __shfl_xor(as_[m], 32); }
#pragma unroll
            for (int m = 0; m < 4; ++m) {
                const float rsC = rsqrtf(cs[m] * (1.f / 1024.f) + EPS); const float sA = as_[m] * (1.f / 512.f) + EPS; const float rsA = rsqrtf(sA);
                hk[ai * 4 + m] = rsA; const float f = rsC * sA * rsA;
#pragma unroll
                for (int bj = 0; bj < 2; ++bj)
#pragma unroll
                    for (int n = 0; n < 2; ++n) acc[ai][bj][m][n] = acc[ai][bj][m][n] * f; }
            __builtin_amdgcn_sched_barrier(0);
        }
    }
    __device__ __forceinline__ void hook2(f32x4 (&acc)[2][2][4][2], const float (&hk)[8]) const {
#pragma unroll
        for (int ai = 0; ai < 2; ++ai)
#pragma unroll
            for (int m = 0; m < 4; ++m)
#pragma unroll
                for (int bj = 0; bj < 2; ++bj)
#pragma unroll
                    for (int n = 0; n < 2; ++n) acc[ai][bj][m][n] = acc[ai][bj][m][n] * hk[ai * 4 + m];
    }
    __device__ __forceinline__ void operator()(const f32x4 (&acc)[2][2][4][2], const Unit& u, int wr, int wc, int fr, int fq) const {
        const int row0 = u.pm * BM + wr * 64 + fr, col0 = u.pn * BM + wc * 32 + 4 * fq;
#pragma unroll
        for (int ai = 0; ai < 2; ++ai)
#pragma unroll
            for (int m = 0; m < 4; ++m) { const int row = row0 + ai * HALF + m * 16; const size_t ro = (size_t)row * D_MODEL + col0; float ss = 0.f;
#pragma unroll
                for (int bj = 0; bj < 2; ++bj)
#pragma unroll
                    for (int n = 0; n < 2; ++n) { const size_t o = ro + bj * HALF + n * 16; const f32x4 v = *(const f32x4*)(in + o) + acc[ai][bj][m][n]; *(f32x4*)(out + o) = v;
                        u32x2 w; w.x = cvt_pk_bf16(v[0], v[1]); w.y = cvt_pk_bf16(v[2], v[3]); *(u32x2*)(hb + o) = w; ss += (v[0] * v[0] + v[1] * v[1]) + (v[2] * v[2] + v[3] * v[3]); }
                ss += __shfl_xor(ss, 16); ss += __shfl_xor(ss, 32);
                if (fq == 0) ssq2[row * 32 + u.pn * 4 + wc] = ss; }
    }
};
}


#define XB_TMO      128
#define XB_XCNT(j)  (256  + 64 * (j))
#define XB_XSUB(j)  (1280 + 64 * (j))
#define XB_XGEN(j)  (2304 + 64 * (j))
#define XB_TOP      3328
#define XB_TOPGEN   3392
#define XCD_BAR_WORDS 3456
#define XB_SPIN_CAP (1u << 22)
__device__ __forceinline__ unsigned xb_ld(unsigned* p)              { return __hip_atomic_load(p, __ATOMIC_RELAXED, __HIP_MEMORY_SCOPE_AGENT); }
__device__ __forceinline__ unsigned xb_add(unsigned* p, unsigned v) { return __hip_atomic_fetch_add(p, v, __ATOMIC_RELAXED, __HIP_MEMORY_SCOPE_AGENT); }
__device__ __forceinline__ unsigned xb_xcc_id() { return (unsigned)__builtin_amdgcn_s_getreg((3 << 11) | 20) & 0xFu; }
#define XB_SPIN(cond, bar) do { unsigned _sp = 0; while (cond) { __builtin_amdgcn_s_sleep(1); \
    if ((++_sp & 255u) == 0u) { if (xb_ld(&(bar)[XB_TMO])) break; if (_sp > XB_SPIN_CAP) { atomicAdd(&(bar)[XB_TMO], 1u); break; } } } } while (0)
struct XcdBarrier { unsigned* bar; unsigned x; volatile PG8_LAS unsigned* st; };
__device__ __forceinline__ XcdBarrier xcd_barrier_post(unsigned* bar, volatile PG8_LAS unsigned* st, int wv) {
    XcdBarrier b; b.bar = bar; b.x = xb_xcc_id(); b.st = st;
    if (otid(wv) == 0) (void)xb_add(&bar[XB_XCNT(b.x)], 1u);
    return b;
}
__device__ __forceinline__ void xcd_barrier_complete(unsigned* bar, unsigned x, unsigned& nloc, unsigned& nx) {
    const unsigned G = gridDim.x * gridDim.y * gridDim.z;
    unsigned sum, cnt, mine, sp = 0u;
    for (;;) {
        sum = 0u; cnt = 0u; mine = 0u;
#pragma unroll
        for (unsigned j = 0; j < 16; ++j) { const unsigned c = xb_ld(&bar[XB_XCNT(j)]); sum += c; cnt += (c > 0u) ? 1u : 0u; mine = (j == x) ? c : mine; }
        if (sum == G) break;
        __builtin_amdgcn_s_sleep(1);
        if ((++sp & 255u) == 0u) { if (xb_ld(&bar[XB_TMO])) break; if (sp > XB_SPIN_CAP) { atomicAdd(&bar[XB_TMO], 1u); break; } }
    }
    nloc = mine > 0u ? mine : 1u; nx = cnt > 0u ? cnt : 1u;
}
__device__ __forceinline__ void xcd_barrier(const XcdBarrier& b, int wv) {
    asm volatile("s_waitcnt vmcnt(0)" ::: "memory");
    __syncthreads();
    if (otid(wv) == 0) {
        unsigned* bar = b.bar;
        __builtin_amdgcn_s_waitcnt(0);
        unsigned nloc = b.st[0], nx = b.st[1];
        if (nloc == 0u) { xcd_barrier_complete(bar, b.x, nloc, nx); b.st[0] = nloc; b.st[1] = nx; }
        const unsigned old = xb_add(&bar[XB_XSUB(b.x)], 1u);
        const unsigned gen = old / nloc;
        if (old + 1u == (gen + 1u) * nloc) {
            __builtin_amdgcn_fence(__ATOMIC_RELEASE, "agent");
            asm volatile("s_waitcnt vmcnt(0)" ::: "memory");
            const unsigned og = xb_add(&bar[XB_TOP], 1u);
            const unsigned tg = og / nx;
            if (og + 1u == (tg + 1u) * nx) xb_add(&bar[XB_TOPGEN], 1u);
            else XB_SPIN(xb_ld(&bar[XB_TOPGEN]) == tg, bar);
            __builtin_amdgcn_fence(__ATOMIC_ACQUIRE, "agent");
            xb_add(&bar[XB_XGEN(b.x)], 1u);
            asm volatile("s_waitcnt vmcnt(0)" ::: "memory");
        } else {
            XB_SPIN(xb_ld(&bar[XB_XGEN(b.x)]) == gen, bar);
            __builtin_amdgcn_fence(__ATOMIC_ACQUIRE, "agent");
            asm volatile("s_waitcnt vmcnt(0)" ::: "memory");
        }
    }
    __syncthreads();
}

namespace att {
constexpr int QPARK_OFF = 8 * 128 * 64 * 2 + 16 + 4096;
constexpr int DQ = 192, NW = 8, QBLK = 32, KVBLK = 64;
constexpr float SCALE = 0.07216878364870322f;
constexpr float THR = 8.f;
constexpr int LDQ = 192, LDK = 192, LDV = 2048;
constexpr int SHM_V = KVBLK * 128 * 2, SHM_K = KVBLK * DQ * 2, OFF_K = 3 * SHM_V, OFF_W = OFF_K + 3 * SHM_K, SHM_ATTN = OFF_W + NW * 64 * 4, NQREG = 12, SHM_QPARK = (12 - NQREG) * 512 * 16;
#define KSWZ(row, colB) ((row) * 384 + ((colB) ^ ((((row) >> 1) & 7) << 4)))
#define SBAR() __builtin_amdgcn_sched_barrier(0)
__device__ __forceinline__ int crow(int r, int hi) { return (r & 3) + 8 * (r >> 2) + 4 * hi; }
__device__ __forceinline__ void partialSM(f32x16& p0, f32x16& p1, float& m_reg, float& mn, float& alpha) {
    constexpr float C = SCALE * 1.4426950408889634f;
    float pmax = p0[0];
#pragma unroll
    for (int r = 1; r < 16; ++r) pmax = fmaxf(pmax, p0[r]);
#pragma unroll
    for (int r = 0; r < 16; ++r) pmax = fmaxf(pmax, p1[r]);
    { auto rr = __builtin_amdgcn_permlane32_swap(__float_as_uint(pmax), __float_as_uint(pmax), false, false);
      pmax = fmaxf(__uint_as_float(rr[0]), __uint_as_float(rr[1])); }
    if (__builtin_expect(__all(pmax - m_reg <= THR / SCALE), 1)) { mn = m_reg; alpha = 1.f; }
    else { mn = fmaxf(m_reg, pmax); alpha = __builtin_amdgcn_exp2f((m_reg - mn) * C); m_reg = mn; }
    float mnC = -mn * C;
#pragma unroll
    for (int r = 0; r < 16; ++r) p0[r] = fmaf(p0[r], C, mnC);
#pragma unroll
    for (int r = 0; r < 16; ++r) p1[r] = fmaf(p1[r], C, mnC);
#pragma unroll
    for (int r = 0; r < 16; ++r) p0[r] = __builtin_amdgcn_exp2f(p0[r]);
}
__device__ __forceinline__ void finishSM(f32x16& p0, f32x16& p1, float alpha, float& l_reg, bf16x8& pa0, bf16x8& pa1, bf16x8& pa2, bf16x8& pa3) {
#pragma unroll
    for (int r = 0; r < 16; ++r) p1[r] = __builtin_amdgcn_exp2f(p1[r]);
    float ps = 0;
#pragma unroll
    for (int r = 0; r < 16; ++r) ps += p0[r];
#pragma unroll
    for (int r = 0; r < 16; ++r) ps += p1[r];
    { auto rr = __builtin_amdgcn_permlane32_swap(__float_as_uint(ps), __float_as_uint(ps), false, false);
      ps = __uint_as_float(rr[0]) + __uint_as_float(rr[1]); }
    l_reg = l_reg * alpha + ps;
#define PK4(P, BASE, OUT) do { unsigned a0 = cvt_pk_bf16(P[BASE + 0], P[BASE + 1]), a1 = cvt_pk_bf16(P[BASE + 2], P[BASE + 3]);   \
    unsigned b0 = cvt_pk_bf16(P[BASE + 4], P[BASE + 5]), b1 = cvt_pk_bf16(P[BASE + 6], P[BASE + 7]);                              \
    auto r0 = __builtin_amdgcn_permlane32_swap(a0, b0, false, false); auto r1 = __builtin_amdgcn_permlane32_swap(a1, b1, false, false); \
    u32x4 w = {r0[0], r1[0], r0[1], r1[1]}; OUT = *reinterpret_cast<bf16x8*>(&w); } while (0)
    PK4(p0, 0, pa0); PK4(p0, 8, pa1); PK4(p1, 0, pa2); PK4(p1, 8, pa3);
#undef PK4
}
template <int OFF> __device__ __forceinline__ bf16x8 k_read(int a) { bf16x8 r; asm volatile("ds_read_b128 %0, %1 offset:%2" : "=&v"(r) : "v"(a), "i"(OFF) : "memory"); return r; }
constexpr int KDEPTH = 3;
template <int D0> __device__ __forceinline__ void k_pair(bf16x8& b0, bf16x8& b1, const int* ka) { b0 = k_read<(D0 >> 2) * 128>(ka[D0 & 3]); b1 = k_read<(D0 >> 2) * 128 + 32 * 384>(ka[D0 & 3]); }
template <int N> __device__ __forceinline__ void lgkm_wait(bf16x8& a, bf16x8& b) { asm volatile("s_waitcnt lgkmcnt(%2)" : "+v"(a), "+v"(b) : "n"(N) : "memory"); }
template <int D0> __device__ __forceinline__ void qkt_step(f32x16& p0, f32x16& p1, const bf16x8* qr, const int* ka, bf16x8 (&f0)[4], bf16x8 (&f1)[4]) {
    if constexpr (D0 + KDEPTH < 12) k_pair<D0 + KDEPTH>(f0[(D0 + KDEPTH) & 3], f1[(D0 + KDEPTH) & 3], ka);
    constexpr int younger = ((11 - D0) < KDEPTH ? (11 - D0) : KDEPTH) * 2;
    lgkm_wait<younger>(f0[D0 & 3], f1[D0 & 3]);
    p0 = __builtin_amdgcn_mfma_f32_32x32x16_bf16(f0[D0 & 3], qr[D0], p0, 0, 0, 0);
    p1 = __builtin_amdgcn_mfma_f32_32x32x16_bf16(f1[D0 & 3], qr[D0], p1, 0, 0, 0);
}
__device__ __forceinline__ void qkt(f32x16& p0, f32x16& p1, int kbase, const bf16x8* qr, const int* ko, const char*  ) {
    p0 = f32x16{}; p1 = f32x16{};
    int ka[4];
#pragma unroll
    for (int e = 0; e < 4; ++e) ka[e] = kbase + ko[e];
    bf16x8 f0[4], f1[4];
    k_pair<0>(f0[0], f1[0], ka); k_pair<1>(f0[1], f1[1], ka); if constexpr (KDEPTH > 2) k_pair<2>(f0[2], f1[2], ka);
    qkt_step<0>(p0, p1, qr, ka, f0, f1); qkt_step<1>(p0, p1, qr, ka, f0, f1); qkt_step<2>(p0, p1, qr, ka, f0, f1); qkt_step<3>(p0, p1, qr, ka, f0, f1);
    qkt_step<4>(p0, p1, qr, ka, f0, f1); qkt_step<5>(p0, p1, qr, ka, f0, f1); qkt_step<6>(p0, p1, qr, ka, f0, f1); qkt_step<7>(p0, p1, qr, ka, f0, f1);
    qkt_step<8>(p0, p1, qr, ka, f0, f1); qkt_step<9>(p0, p1, qr, ka, f0, f1); qkt_step<10>(p0, p1, qr, ka, f0, f1); qkt_step<11>(p0, p1, qr, ka, f0, f1);
}
__device__ __forceinline__ int v_st(int k, int c) { const int kk = (k & ~0xC) | ((k & 4) << 1) | ((k & 8) >> 1); return ((kk >> 3) * 4 + (c >> 5)) * 512 + ((kk & 7) * 32 + (c & 31)) * 2; }
__device__ __forceinline__ int v_rd_base(int lane) { return ((lane & 3) << 3) | (((lane >> 2) & 3) << 6) | (((lane >> 4) & 1) << 5) | (((lane >> 5) & 1) << 8); }
constexpr int v_rd_off(int d0, int ks, int half) { return d0 * 512 + ks * 4096 + half * 2048; }
template <int OFF> __device__ __forceinline__ s16x4 tr_read(int vb) {
    s16x4 r; asm volatile("ds_read_b64_tr_b16 %0, %1 offset:%2" : "=&v"(r) : "v"(vb), "i"(OFF) : "memory"); return r;
}
struct VFrag { s16x4 l0, h0, l1, h1, l2, h2, l3, h3; };
template <int D0> __device__ __forceinline__ void v_read8(VFrag& f, int vb) {
    f.l0 = tr_read<v_rd_off(D0, 0, 0)>(vb); f.h0 = tr_read<v_rd_off(D0, 0, 1)>(vb); f.l1 = tr_read<v_rd_off(D0, 1, 0)>(vb); f.h1 = tr_read<v_rd_off(D0, 1, 1)>(vb);
    f.l2 = tr_read<v_rd_off(D0, 2, 0)>(vb); f.h2 = tr_read<v_rd_off(D0, 2, 1)>(vb); f.l3 = tr_read<v_rd_off(D0, 3, 0)>(vb); f.h3 = tr_read<v_rd_off(D0, 3, 1)>(vb);
}
__device__ __forceinline__ void pv_mma4(f32x16& od, const VFrag& f, bf16x8 pa0, bf16x8 pa1, bf16x8 pa2, bf16x8 pa3) {
#define PK(L, H) (bf16x8){L[0], L[1], L[2], L[3], H[0], H[1], H[2], H[3]}
    od = __builtin_amdgcn_mfma_f32_32x32x16_bf16(pa0, PK(f.l0, f.h0), od, 0, 0, 0);
    od = __builtin_amdgcn_mfma_f32_32x32x16_bf16(pa1, PK(f.l1, f.h1), od, 0, 0, 0);
    od = __builtin_amdgcn_mfma_f32_32x32x16_bf16(pa2, PK(f.l2, f.h2), od, 0, 0, 0);
    od = __builtin_amdgcn_mfma_f32_32x32x16_bf16(pa3, PK(f.l3, f.h3), od, 0, 0, 0);
#undef PK
}
__device__ __forceinline__ void pv_d0_1(f32x16* o, int vb, bf16x8 pa0, bf16x8 pa1, bf16x8 pa2, bf16x8 pa3) {
    VFrag f;
    v_read8<0>(f, vb); asm volatile("s_waitcnt lgkmcnt(0)" ::: "memory"); SBAR(); pv_mma4(o[0], f, pa0, pa1, pa2, pa3); SBAR();
    v_read8<1>(f, vb); asm volatile("s_waitcnt lgkmcnt(0)" ::: "memory"); SBAR(); pv_mma4(o[1], f, pa0, pa1, pa2, pa3); SBAR();
    v_read8<2>(f, vb); asm volatile("s_waitcnt lgkmcnt(0)" ::: "memory"); SBAR(); pv_mma4(o[2], f, pa0, pa1, pa2, pa3); SBAR();
    v_read8<3>(f, vb); asm volatile("s_waitcnt lgkmcnt(0)" ::: "memory"); SBAR(); pv_mma4(o[3], f, pa0, pa1, pa2, pa3);
}
__device__ __forceinline__ void pv_d0(f32x16* o, int vb, bf16x8 pa0, bf16x8 pa1, bf16x8 pa2, bf16x8 pa3) {
    VFrag fa, fb;
    v_read8<0>(fa, vb); v_read8<1>(fb, vb);
    asm volatile("s_waitcnt lgkmcnt(8)" ::: "memory"); SBAR(); pv_mma4(o[0], fa, pa0, pa1, pa2, pa3); SBAR();
    v_read8<2>(fa, vb);
    asm volatile("s_waitcnt lgkmcnt(8)" ::: "memory"); SBAR(); pv_mma4(o[1], fb, pa0, pa1, pa2, pa3); SBAR();
    v_read8<3>(fb, vb);
    asm volatile("s_waitcnt lgkmcnt(8)" ::: "memory"); SBAR(); pv_mma4(o[2], fa, pa0, pa1, pa2, pa3); SBAR();
    asm volatile("s_waitcnt lgkmcnt(0)" ::: "memory"); SBAR(); pv_mma4(o[3], fb, pa0, pa1, pa2, pa3);
}
__device__ __forceinline__ void attn_body(const bf16_t* __restrict__ Qb, const bf16_t* __restrict__ Kh, const bf16_t* __restrict__ Vh,
                                          const bf16_t* __restrict__ Zb, bf16_t* __restrict__ Yb, float* __restrict__ Sq, int seq, char* lds, int wv) {
    const int tid = otid(wv), wid = __builtin_amdgcn_readfirstlane(tid >> 6), lane = tid & 63, r32 = lane & 31, hi = lane >> 5;
    PG8_LAS char* l3 = (PG8_LAS char*)lds;
    char* V_lds = lds; char* K_lds = lds + OFF_K;
    float* wsl = (float*)(lds + OFF_W) + wid * 64; float* li_l = wsl; float* al_l = wsl + 32;
    float m_reg = -1e30f, l_reg = 0; f32x16 o[4] = {}; bf16x8 qr[NQREG];
    char* qrl = lds + QPARK_OFF + tid * 16;
    const bf16_t* Qw = Qb + (long)(wid * QBLK + r32) * LDQ + hi * 8;
#pragma unroll
    for (int d0 = 0; d0 < NQREG; ++d0) qr[d0] = *reinterpret_cast<const bf16x8*>(Qw + d0 * 16);
#pragma unroll
    for (int d0 = NQREG; d0 < 12; ++d0) *reinterpret_cast<bf16x8*>(qrl + (d0 - NQREG) * 8192) = *reinterpret_cast<const bf16x8*>(Qw + d0 * 16);
    int kg[3], vg[2];
#pragma unroll
    for (int i = 0; i < 3; ++i) { const int p = (wid * 3 + i) * 64 + lane, row = p / 24, cp = p % 24, c = cp ^ ((row >> 1) & 7); kg[i] = row * LDK + c * 8; }
#pragma unroll
    for (int i = 0; i < 2; ++i) { const int sl = (wid * 2 + i) * 64 + lane, kk = ((sl >> 7) << 3) | ((sl >> 2) & 7), c = ((sl >> 5) & 3) * 32 + (sl & 3) * 8;
        const int k = (kk & ~0xC) | ((kk & 4) << 1) | ((kk & 8) >> 1); vg[i] = k * LDV + c; }
    const int vb0 = (int)(uintptr_t)V_lds + v_rd_base(lane);
    const int klds_i = (int)(uintptr_t)K_lds;
    int ko[4];
#pragma unroll
    for (int e = 0; e < 4; ++e) ko[e] = r32 * 384 + (((e * 2 + hi) ^ ((r32 >> 1) & 7)) << 4);
#define KISSUE(tile, buf) do { const bf16_t* Kt_ = Kh + (size_t)(tile) * (KVBLK * LDK); _Pragma("unroll") for (int i_ = 0; i_ < 3; ++i_) \
    __builtin_amdgcn_global_load_lds((const unsigned*)(Kt_ + kg[i_]), (PG8_LAS unsigned*)(l3 + OFF_K + (buf) * SHM_K + (wid * 3 + i_) * 1024), 16, 0, 0); } while (0)
#define VISSUE(tile, buf) do { const bf16_t* Vt_ = Vh + (size_t)(tile) * (KVBLK * LDV); _Pragma("unroll") for (int i_ = 0; i_ < 2; ++i_) \
    __builtin_amdgcn_global_load_lds((const unsigned*)(Vt_ + vg[i_]), (PG8_LAS unsigned*)(l3 + (buf) * SHM_V + (wid * 2 + i_) * 1024), 16, 0, 0); } while (0)
#define WAITV(n) asm volatile("s_waitcnt vmcnt(" #n ")" ::: "memory")
#define WBAR() do { __builtin_amdgcn_s_barrier(); asm volatile("" ::: "memory"); } while (0)
#define NEXT3(x) ((x) == 2 ? 0 : (x) + 1)
#define RESC(a) do { if (__any((a) < 1.f)) { if (hi == 0) al_l[r32] = (a); asm volatile("s_waitcnt lgkmcnt(0)" ::: "memory"); \
    _Pragma("unroll") for (int d = 0; d < 4; ++d) _Pragma("unroll") for (int r = 0; r < 16; ++r) o[d][r] *= al_l[crow(r, hi)]; } } while (0)
    f32x16 pA0, pA1, pB0, pB1; float mnA, mnB, alA, alB; bf16x8 pa0, pa1, pa2, pa3; const int NT = seq / KVBLK;
    WAITV(0);
    KISSUE(0, 0);
    KISSUE(1, 1); VISSUE(0, 0);
    WAITV(5); WBAR();
    KISSUE(2, 2); VISSUE(1, 1);
    qkt(pA0, pA1, klds_i, qr, ko, qrl); partialSM(pA0, pA1, m_reg, mnA, alA);
    int kb = 1, vbi = 0;
    const int half = wid >> 2;
#define STEP_A(PC0, PC1, MNC, ALC, PP0, PP1, ALP) do { \
        SBAR(); qkt(PC0, PC1, klds_i + kb * SHM_K, qr, ko, qrl); \
        finishSM(PP0, PP1, ALP, l_reg, pa0, pa1, pa2, pa3); SBAR(); \
        pv_d0(o, vb0 + vbi * SHM_V, pa0, pa1, pa2, pa3); partialSM(PC0, PC1, m_reg, MNC, ALC); \
        RESC(ALC); kb = NEXT3(kb); vbi = NEXT3(vbi); } while (0)
#define STEP_B(PC0, PC1, MNC, ALC, PP0, PP1, ALP) do { \
        SBAR(); finishSM(PP0, PP1, ALP, l_reg, pa0, pa1, pa2, pa3); SBAR(); \
        qkt(PC0, PC1, klds_i + kb * SHM_K, qr, ko, qrl); SBAR(); \
        partialSM(PC0, PC1, m_reg, MNC, ALC); SBAR(); \
        pv_d0_1(o, vb0 + vbi * SHM_V, pa0, pa1, pa2, pa3); \
        RESC(ALC); kb = NEXT3(kb); vbi = NEXT3(vbi); } while (0)
#define MAINLOOP(STEP) for (int j = 1; j + 1 < NT; j += 2) { \
        WAITV(5); WBAR(); \
        { const int k2 = NEXT3(NEXT3(kb)), v1 = NEXT3(NEXT3(vbi)); KISSUE(j + 2, k2); VISSUE(j + 1, v1); } \
        STEP(pB0, pB1, mnB, alB, pA0, pA1, alA); \
        WAITV(5); WBAR(); \
        { const int k2 = NEXT3(NEXT3(kb)), v1 = NEXT3(NEXT3(vbi)); if (j + 3 < NT) KISSUE(j + 3, k2); VISSUE(j + 2, v1); } \
        STEP(pA0, pA1, mnA, alA, pB0, pB1, alB); }
    (void)half; MAINLOOP(STEP_A)
    WAITV(0); WBAR();
    SBAR(); qkt(pB0, pB1, klds_i + kb * SHM_K, qr, ko, qrl);
    finishSM(pA0, pA1, alA, l_reg, pa0, pa1, pa2, pa3); SBAR();
    pv_d0(o, vb0 + vbi * SHM_V, pa0, pa1, pa2, pa3); partialSM(pB0, pB1, m_reg, mnB, alB);
    RESC(alB);
    vbi = NEXT3(vbi);
    finishSM(pB0, pB1, alB, l_reg, pa0, pa1, pa2, pa3); SBAR();
    pv_d0(o, vb0 + vbi * SHM_V, pa0, pa1, pa2, pa3);
    if (hi == 0) li_l[r32] = l_reg; asm volatile("s_waitcnt lgkmcnt(0)" ::: "memory");
    int er = wid * QBLK + 4 * hi; asm volatile("" : "+v"(er));
#pragma unroll
    for (int r = 0; r < 16; ++r) { const int ro = er + (r & 3) + 8 * (r >> 2); const float rli = __builtin_amdgcn_rcpf(li_l[ro - wid * QBLK]);
        const bf16_t* zp = Zb + ro * LDP + r32; bf16_t* yp = Yb + ro * 2048 + r32; float sq = 0.f;
#pragma unroll
        for (int d0 = 0; d0 < 4; ++d0) { const float z = bf2f(zp[d0 * 32]); const float y = o[d0][r] * rli * silu(z); sq += y * y; yp[d0 * 32] = f2bf(y); }
        sq += __shfl_xor(sq, 1); sq += __shfl_xor(sq, 2); sq += __shfl_xor(sq, 4); sq += __shfl_xor(sq, 8); sq += __shfl_xor(sq, 16);
        if (r32 == 0) Sq[ro * 8] = sq; }
    __syncthreads();
#undef STEP_A
#undef STEP_B
#undef MAINLOOP
#undef KISSUE
#undef VISSUE
#undef WAITV
#undef WBAR
#undef NEXT3
#undef RESC
}
}

struct TrJob { const float* W; const float* gain; bf16_t* Wt; int K, N, Npad, krot; };
__device__ __forceinline__ void tr_load(const TrJob& J, int tile, int tid, f32x4 (&v)[8]) {
    const int ntn = J.Npad / 128, tk = tile / ntn, tn = tile % ntn, k0 = tk * 128, n0 = tn * 128, c4 = (tid & 31) * 4, r0 = tid >> 5;
#pragma unroll
    for (int i = 0; i < 8; ++i) { const int k = k0 + r0 + i * 16; f32x4 x = (f32x4){0.f, 0.f, 0.f, 0.f};
        if (n0 + c4 < J.N) { x = *(const f32x4*)(J.W + (size_t)k * J.N + n0 + c4); if (J.gain) { const float g = J.gain[k]; x = x * g; } }
        v[i] = x; }
}
constexpr int TR_IN = (2048 / 128) * (LDP / 128), TR_UKV = (512 / 128) * (2048 / 128), TR_SQ = (2048 / 128) * (2048 / 128), TR_PP = (256 / 128) * (2048 / 128);
constexpr int TR_E0 = DEPTH * TR_IN, TR_E1 = TR_E0 + DEPTH * TR_UKV, TR_E2 = TR_E1 + DEPTH * TR_SQ, TR_E3 = TR_E2 + DEPTH * TR_SQ, TR_E4 = TR_E3 + DEPTH * TR_PP;
__device__ __forceinline__ TrJob tr_decode(KPtr P, int g, int& tile) {
    unsigned char* ws = P->ws; TrJob J;
    if (g < TR_E0) { const int l = g / TR_IN; tile = g - l * TR_IN; J = TrJob{P->w_in + (size_t)l * 2048 * IN_W, P->attn_norm + l * 2048, (bf16_t*)(ws + WS_WT_IN) + (size_t)l * LDP * 2048, 2048, IN_W, LDP, 0}; }
    else if (g < TR_E1) { const int q = g - TR_E0, l = q / TR_UKV; tile = q - l * TR_UKV; J = TrJob{P->w_ukv + (size_t)l * 512 * 2048, P->kv_norm + l * 512, (bf16_t*)(ws + WS_WT_UKV) + (size_t)l * 2048 * 512, 512, 2048, 2048, 0}; }
    else if (g < TR_E2) { const int q = g - TR_E1, l = q / TR_SQ; tile = q - l * TR_SQ; J = TrJob{P->w_out + (size_t)l * 2048 * 2048, P->out_norm + l * 2048, (bf16_t*)(ws + WS_WT_OUT) + (size_t)l * 2048 * 2048, 2048, 2048, 2048, 1024}; }
    else if (g < TR_E3) { const int q = g - TR_E2, l = q / TR_SQ; tile = q - l * TR_SQ; J = TrJob{P->w_ple_gate + (size_t)l * 2048 * 2048, P->ple_norm + l * 2048, (bf16_t*)(ws + WS_WT_G) + (size_t)l * 2048 * 2048, 2048, 2048, 2048, 0}; }
    else { const int q = g - TR_E3, l = q / TR_PP; tile = q - l * TR_PP; J = TrJob{P->w_ple_proj + (size_t)l * 256 * 2048, nullptr, (bf16_t*)(ws + WS_WT_PP) + (size_t)l * 2048 * 256, 256, 2048, 2048, 0}; }
    return J;
}
__device__ __forceinline__ void transpose_flat(KPtr P, float* lds, int wv) {
    const int tid = otid(wv);
    int g = blockIdx.x; if (g >= TR_E4) return;
    int tile; TrJob J = tr_decode(P, g, tile);
    f32x4 v[8]; tr_load(J, tile, tid, v);
    for (;;) {
        const int c4 = (tid & 31) * 4, r0 = tid >> 5;
#pragma unroll
        for (int i = 0; i < 8; ++i) { float* d = lds + (r0 + i * 16) * 129 + c4; d[0] = v[i][0]; d[1] = v[i][1]; d[2] = v[i][2]; d[3] = v[i][3]; }
        __syncthreads();
        const TrJob Jc = J; const int cur = tile; g += gridDim.x; const bool more = g < TR_E4;
        if (more) { J = tr_decode(P, g, tile); tr_load(J, tile, tid, v); }
        const int ntn = Jc.Npad / 128, tk = cur / ntn, tn = cur % ntn, k0 = tk * 128, n0 = tn * 128;
#pragma unroll
        for (int j = 0; j < 4; ++j) { const int c = tid + j * 512, kc = c & 15, n = c >> 4; const float* sp = lds + (kc * 8) * 129 + n;
            u32x4 w; w.x = cvt_pk_bf16(sp[0], sp[129]); w.y = cvt_pk_bf16(sp[2 * 129], sp[3 * 129]); w.z = cvt_pk_bf16(sp[4 * 129], sp[5 * 129]); w.w = cvt_pk_bf16(sp[6 * 129], sp[7 * 129]);
            *(u32x4*)(Jc.Wt + (size_t)(n0 + n) * Jc.K + ((k0 + Jc.krot) % Jc.K) + kc * 8) = w; }
        __syncthreads();
        if (!more) break;
    }
}
__device__ void phase_prep(KPtr P, float* lds, int wv) {
    unsigned char* ws = P->ws;
    transpose_flat(P, lds, wv);
    { const size_t n4 = (size_t)DEPTH * T * PLE / 4; const f32x4* src = (const f32x4*)P->p; u32x2* dst = (u32x2*)(ws + WS_PB);
      for (size_t i = (size_t)blockIdx.x * NTHR + otid(wv); i < n4; i += (size_t)gridDim.x * NTHR) { const f32x4 v = src[i]; u32x2 w; w.x = cvt_pk_bf16(v[0], v[1]); w.y = cvt_pk_bf16(v[2], v[3]); dst[i] = w; } }
    { float* cs = (float*)(ws + WS_COS); float* sn = (float*)(ws + WS_SIN);
      for (int i = blockIdx.x * NTHR + otid(wv); i < T * 32; i += gridDim.x * NTHR) { const int t = i >> 5, f = i & 31;
          const double inv = exp(-(double)(2 * f) / 64.0 * 9.210340371976184); const double ang = (double)P->positions[t] * inv; cs[i] = (float)cos(ang); sn[i] = (float)sin(ang); } }
}
__device__ void phase_rownorm(const float* __restrict__ src, bf16_t* __restrict__ dst, int wv) {
    const int tid = otid(wv), wid = tid >> 6, lane = tid & 63, stride = gridDim.x * 8;
    int row = blockIdx.x * 8 + wid; f32x4 v[8], nv[8];
    if (row < T) { const f32x4* p = (const f32x4*)(src + (size_t)row * 2048);
#pragma unroll
        for (int j = 0; j < 8; ++j) v[j] = p[lane + 64 * j]; }
    for (; row < T; row += stride) {
        const int rn = row + stride; const bool more = rn < T;
        if (more) { const f32x4* p = (const f32x4*)(src + (size_t)rn * 2048);
#pragma unroll
            for (int j = 0; j < 8; ++j) nv[j] = p[lane + 64 * j]; }
        float ss = 0.f;
#pragma unroll
        for (int j = 0; j < 8; ++j) ss += v[j][0] * v[j][0] + v[j][1] * v[j][1] + v[j][2] * v[j][2] + v[j][3] * v[j][3];
        ss = wave_sum(ss); const float rs = rsqrtf(ss * (1.f / 2048.f) + EPS);
        u32x2* d = (u32x2*)(dst + (size_t)row * 2048);
#pragma unroll
        for (int j = 0; j < 8; ++j) { u32x2 w; w.x = cvt_pk_bf16(v[j][0] * rs, v[j][1] * rs); w.y = cvt_pk_bf16(v[j][2] * rs, v[j][3] * rs); d[lane + 64 * j] = w; }
        if (more) {
#pragma unroll
            for (int j = 0; j < 8; ++j) v[j] = nv[j]; }
    }
}
__device__ void phase_post_rows(KPtr P, int l, int wv) {
    unsigned char* ws = P->ws; const bf16_t* __restrict__ PROJ = (const bf16_t*)(ws + WS_PROJ); bf16_t* __restrict__ Q = (bf16_t*)(ws + WS_Q); bf16_t* __restrict__ Kb = (bf16_t*)(ws + WS_K);
    bf16_t* __restrict__ CK = (bf16_t*)(ws + WS_CKVN); bf16_t* __restrict__ Y = (bf16_t*)(ws + WS_Y); const float* __restrict__ COS = (const float*)(ws + WS_COS); const float* __restrict__ SIN = (const float*)(ws + WS_SIN);
    const int tid = otid(wv), wid = tid >> 6, lane = tid & 63, h = lane >> 3, sub = lane & 7, ch = lane * 8, fi = (sub & 3) * 8;
    float gqn[16], gqr[8], gkr[8], w0[8], w1[8], w2[8], cb[8];
    { const float* qn_g = P->q_nope_norm + l * 128 + sub * 16; const float* qr_g = P->q_rope_norm + l * 64 + sub * 8; const float* kr_g = P->k_rope_norm + l * 64 + sub * 8;
      const float* cw = P->conv_w + (size_t)l * 3 * 512 + ch; const float* cbias = P->conv_b + (size_t)l * 512 + ch;
#pragma unroll
      for (int e = 0; e < 16; ++e) gqn[e] = qn_g[e];
#pragma unroll
      for (int e = 0; e < 8; ++e) { gqr[e] = qr_g[e]; gkr[e] = kr_g[e]; w0[e] = cw[e]; w1[e] = cw[512 + e]; w2[e] = cw[1024 + e]; cb[e] = cbias[e]; } }
    for (int t = blockIdx.x * 8 + wid; t < T; t += gridDim.x * 8) {
        const int b = t / SEQ, s = t % SEQ; const bf16_t* pr = PROJ + (size_t)t * LDP;
        const size_t qo = ((size_t)(b * 8 + h) * SEQ + s) * 192;
        const bool hasm = s > 0, hasp = s < SEQ - 1; const u32x4 zero4 = {0u, 0u, 0u, 0u};
        const u32x4 lqn0 = *(const u32x4*)(pr + OFF_CQ + 192 * h + sub * 16), lqn1 = *(const u32x4*)(pr + OFF_CQ + 192 * h + sub * 16 + 8);
        const u32x4 lqr = *(const u32x4*)(pr + OFF_CQ + 192 * h + 128 + sub * 8), lkr = *(const u32x4*)(pr + OFF_CKR + sub * 8), lkv = *(const u32x4*)(pr + OFF_CKV + ch);
        const u32x4 lbb = *(const u32x4*)(pr + OFF_BB + ch), lc0 = *(const u32x4*)(pr + OFF_BC + ch), lh0 = *(const u32x4*)(pr + OFF_BH + ch), lzz = *(const u32x4*)(pr + OFF_BZ + ch);
        const u32x4 lcm = hasm ? *(const u32x4*)(pr - LDP + OFF_BC + ch) : zero4, lhm = hasm ? *(const u32x4*)(pr - LDP + OFF_BH + ch) : zero4;
        const u32x4 lcp = hasp ? *(const u32x4*)(pr + LDP + OFF_BC + ch) : zero4, lhp = hasp ? *(const u32x4*)(pr + LDP + OFF_BH + ch) : zero4;
        const f32x4 lc0s = *(const f32x4*)(COS + (size_t)t * 32 + fi), lc1s = *(const f32x4*)(COS + (size_t)t * 32 + fi + 4), ls0s = *(const f32x4*)(SIN + (size_t)t * 32 + fi), ls1s = *(const f32x4*)(SIN + (size_t)t * 32 + fi + 4);
        float cs[8], sn[8];
#pragma unroll
        for (int e = 0; e < 4; ++e) { cs[e] = lc0s[e]; cs[4 + e] = lc1s[e]; sn[e] = ls0s[e]; sn[4 + e] = ls1s[e]; }
        {
            float f[16]; unpack8(lqn0, f); unpack8(lqn1, f + 8);
            float ss = 0.f;
#pragma unroll
            for (int e = 0; e < 16; ++e) ss += f[e] * f[e];
            ss = sum8(ss); const float rs = rsqrtf(ss * (1.f / 128.f) + EPS);
#pragma unroll
            for (int e = 0; e < 16; ++e) f[e] = f[e] * rs * gqn[e];
            u32x4* d = (u32x4*)(Q + qo + sub * 16); d[0] = pack8(f); d[1] = pack8(f + 8);
        }
        {
            float f[8]; unpack8(lqr, f);
            float ss = 0.f;
#pragma unroll
            for (int e = 0; e < 8; ++e) ss += f[e] * f[e];
            ss = sum8(ss); const float rs = rsqrtf(ss * (1.f / 64.f) + EPS); float o8[8];
#pragma unroll
            for (int e = 0; e < 8; ++e) { const float xn = f[e] * rs * gqr[e]; const float pt = __shfl_xor(xn, 4);
                o8[e] = (sub < 4) ? (xn * cs[e] - pt * sn[e]) : (xn * cs[e] + pt * sn[e]); }
            *(u32x4*)(Q + qo + 128 + sub * 8) = pack8(o8);
        }
        {
            float f[8]; unpack8(lkr, f);
            float ss = 0.f;
#pragma unroll
            for (int e = 0; e < 8; ++e) ss += f[e] * f[e];
            ss = sum8(ss); const float rs = rsqrtf(ss * (1.f / 64.f) + EPS); float o8[8];
#pragma unroll
            for (int e = 0; e < 8; ++e) { const float xn = f[e] * rs * gkr[e]; const float pt = __shfl_xor(xn, 4);
                o8[e] = (sub < 4) ? (xn * cs[e] - pt * sn[e]) : (xn * cs[e] + pt * sn[e]); }
            *(u32x4*)(Kb + qo + 128 + sub * 8) = pack8(o8);
        }
        {
            float f[8]; unpack8(lkv, f);
            float ss = 0.f;
#pragma unroll
            for (int e = 0; e < 8; ++e) ss += f[e] * f[e];
            ss = wave_sum(ss); const float rs = rsqrtf(ss * (1.f / 512.f) + EPS);
#pragma unroll
            for (int e = 0; e < 8; ++e) f[e] *= rs;
            *(u32x4*)(CK + (size_t)t * 512 + ch) = pack8(f);
        }
        {
            float bb[8], c0[8], h0[8], zz[8], cm[8], hm[8], cp[8], hp[8];
            unpack8(lbb, bb); unpack8(lc0, c0); unpack8(lh0, h0); unpack8(lzz, zz); unpack8(lcm, cm); unpack8(lhm, hm); unpack8(lcp, cp); unpack8(lhp, hp);
            float o8[8]; float ssb = 0.f;
#pragma unroll
            for (int e = 0; e < 8; ++e) { const float y = cb[e] + w0[e] * (cm[e] * hm[e]) + w1[e] * (c0[e] * h0[e]) + w2[e] * (cp[e] * hp[e]);
                o8[e] = bb[e] * y * silu(zz[e]); ssb += o8[e] * o8[e]; }
            ssb = wave_sum(ssb); const float rsb = rsqrtf(ssb * (1.f / 512.f) + EPS);
#pragma unroll
            for (int e = 0; e < 8; ++e) o8[e] *= rsb;
            *(u32x4*)(Y + (size_t)t * 2048 + YB + ch) = pack8(o8);
        }
    }
}
__device__ void phase_sgu(KPtr P, int l, char* lds, int wv) {
    unsigned char* ws = P->ws; const bf16_t* __restrict__ PROJ = (const bf16_t*)(ws + WS_PROJ); bf16_t* __restrict__ Y = (bf16_t*)(ws + WS_Y);
    const int tid = otid(wv), wid = tid >> 6, lane = tid & 63, fr = lane & 15, fq = lane >> 4;
    constexpr int VST = 264;
    for (int unit = blockIdx.x; unit < (T / 128) * 4; unit += gridDim.x) {
        const int k = unit >> 2, h = unit & 3, t0 = k * 128, n0 = wid * 16, t = t0 + n0 + fr;
        bf16_t r0[16], r1[16];
#pragma unroll
        for (int i = 0; i < 16; ++i) { const bf16_t* pv = PROJ + (size_t)(t0 + wid * 16 + i) * LDP + OFF_AV + h * 128; r0[i] = pv[lane]; r1[i] = pv[lane + 64]; }
        const float* sg = P->sgu_norm + (size_t)(l * 4 + h) * 128; const float g0 = sg[lane], g1 = sg[lane + 64];
        const float* wsp = P->w_spatial + ((size_t)(l * 4 + h) * 128 + n0 + fr) * 128 + fq * 8;
        f32x4 wa[4], wc[4];
#pragma unroll
        for (int kk = 0; kk < 4; ++kk) { wa[kk] = *(const f32x4*)(wsp + kk * 32); wc[kk] = *(const f32x4*)(wsp + kk * 32 + 4); }
        const float bias = P->b_spatial[(size_t)(l * 4 + h) * 128 + n0 + fr]; const bf16_t* pr = PROJ + (size_t)t * LDP + h * 128 + fq * 4;
        u32x2 uw[8], zw[8];
#pragma unroll
        for (int ct = 0; ct < 8; ++ct) { uw[ct] = *(const u32x2*)(pr + OFF_AU + ct * 16); zw[ct] = *(const u32x2*)(pr + OFF_AZ + ct * 16); }
#pragma unroll
        for (int i = 0; i < 16; ++i) { const int m = wid * 16 + i;
            const float x0 = bf2f(r0[i]), x1 = bf2f(r1[i]); const float ss = wave_sum(x0 * x0 + x1 * x1); const float rs = rsqrtf(ss * (1.f / 128.f) + EPS);
            *(bf16_t*)(lds + lane * VST + m * 2) = f2bf(x0 * rs * g0); *(bf16_t*)(lds + (lane + 64) * VST + m * 2) = f2bf(x1 * rs * g1); }
        __syncthreads();
        bf16x8 bw[4];
#pragma unroll
        for (int kk = 0; kk < 4; ++kk) { const f32x4 a = wa[kk], c = wc[kk];
            u32x4 w; w.x = cvt_pk_bf16(a[0], a[1]); w.y = cvt_pk_bf16(a[2], a[3]); w.z = cvt_pk_bf16(c[0], c[1]); w.w = cvt_pk_bf16(c[2], c[3]); bw[kk] = *reinterpret_cast<bf16x8*>(&w); }
        f32x4 acc[8];
#pragma unroll
        for (int ct = 0; ct < 8; ++ct) { acc[ct] = (f32x4){0.f, 0.f, 0.f, 0.f};
#pragma unroll
            for (int kk = 0; kk < 4; ++kk) { const char* ap = lds + (ct * 16 + fr) * VST + (kk * 32 + fq * 8) * 2;
                const u32x2 lo = *(const u32x2*)ap, hi2 = *(const u32x2*)(ap + 8); u32x4 w = {lo.x, lo.y, hi2.x, hi2.y};
                acc[ct] = __builtin_amdgcn_mfma_f32_16x16x32_bf16(*reinterpret_cast<bf16x8*>(&w), bw[kk], acc[ct], 0, 0, 0); } }
        float ssa = 0.f;
#pragma unroll
        for (int ct = 0; ct < 8; ++ct) {
            const float v0 = bflo(uw[ct].x) * (acc[ct][0] + bias) * silu(bflo(zw[ct].x)), v1 = bfhi(uw[ct].x) * (acc[ct][1] + bias) * silu(bfhi(zw[ct].x));
            const float v2 = bflo(uw[ct].y) * (acc[ct][2] + bias) * silu(bflo(zw[ct].y)), v3 = bfhi(uw[ct].y) * (acc[ct][3] + bias) * silu(bfhi(zw[ct].y));
            ssa += (v0 * v0 + v1 * v1) + (v2 * v2 + v3 * v3);
            u32x2 w; w.x = cvt_pk_bf16(v0, v1); w.y = cvt_pk_bf16(v2, v3); *(u32x2*)(Y + (size_t)t * 2048 + YA + h * 128 + ct * 16 + fq * 4) = w; }
        ssa += __shfl_xor(ssa, 16); ssa += __shfl_xor(ssa, 32);
        if (fq == 0) ((float*)(ws + WS_SSQA))[(size_t)t * 4 + h] = ssa;
        __syncthreads();
    }
}
__device__ void phase_attn(KPtr P, char* lds, int wv) {
    unsigned char* ws = P->ws; const bf16_t* Q = (const bf16_t*)(ws + WS_Q); const bf16_t* Kb = (const bf16_t*)(ws + WS_K); const bf16_t* KV = (const bf16_t*)(ws + WS_KV);
    const bf16_t* PROJ = (const bf16_t*)(ws + WS_PROJ); bf16_t* Y = (bf16_t*)(ws + WS_Y);
    for (int v = blockIdx.x; v < BATCH * 8 * (SEQ / 256); v += gridDim.x) {
        const int h = v & 7, qb = (v >> 3) & 31, b = v >> 8; const size_t tq = (size_t)b * SEQ + qb * 256;
        att::attn_body(Q + ((size_t)(b * 8 + h) * SEQ + qb * 256) * 192, Kb + (size_t)(b * 8 + h) * SEQ * 192, KV + (size_t)b * SEQ * 2048 + h * 256 + 128,
                       PROJ + tq * LDP + OFF_CZ + h * 128, Y + tq * 2048 + YC + h * 128, (float*)(ws + WS_SSQC) + tq * 8 + h, SEQ, lds, wv);
    }
}

constexpr int LDS_BYTES = pg8::STAGE_BYTES + 16 + 4096 + att::SHM_QPARK;
static_assert(att::QPARK_OFF == pg8::STAGE_BYTES + 16 + 4096 && LDS_BYTES <= 160 * 1024, "LDS map");
static_assert(att::SHM_ATTN <= pg8::STAGE_BYTES, "attention LDS");
__global__ void __launch_bounds__(NTHR, 2) fwd_megakernel(Params P_args) {
    extern __shared__ __attribute__((aligned(16))) unsigned char lds[];
    cg::grid_group grid = cg::this_grid();
    unsigned char* ws = kp_fresh()->ws; const int G = gridDim.x;
    bf16_t* HN = (bf16_t*)(ws + WS_Y); bf16_t* Y = (bf16_t*)(ws + WS_Y); bf16_t* PROJ = (bf16_t*)(ws + WS_PROJ); bf16_t* PPb = (bf16_t*)(ws + WS_PP);
    bf16_t* CK = (bf16_t*)(ws + WS_CKVN); bf16_t* KV = (bf16_t*)(ws + WS_KV); bf16_t* Kb = (bf16_t*)(ws + WS_K);
    PG8_LAS unsigned char* llds = (PG8_LAS unsigned char*)lds;
    volatile PG8_LAS unsigned* bst = (volatile PG8_LAS unsigned*)(llds + pg8::STAGE_BYTES);
    const int wv = __builtin_amdgcn_readfirstlane((int)threadIdx.x >> 6);
    { const int t0_ = otid(wv); if (t0_ < 4) bst[t0_] = 0u; }
    __syncthreads();
    XcdBarrier xb = xcd_barrier_post((unsigned*)(ws + WS_BAR), bst, wv);
#define GSYNC() xcd_barrier(xb, wv)

    phase_prep(kp_fresh(), (float*)lds, wv);
    grid.sync();
    for (int l = 0; l < DEPTH; ++l) {
        const float* hin = (l == 0) ? kp_fresh()->x : kp_fresh()->out;
        phase_rownorm(hin, HN, wv);
        GSYNC();
        { pg8::Gemm g{HN, (const bf16_t*)(ws + WS_WT_IN) + (size_t)l * LDP * 2048, T, LDP, 2048}; pg8::StaticOrder S; S.init(T, LDP, G, (int)blockIdx.x);
          pg8::EpiBf16Store E{PROJ, LDP}; pg8::gemm_phase(llds, g, S, E, wv); }
        GSYNC();
        phase_sgu(kp_fresh(), l, (char*)lds, wv);
        phase_post_rows(kp_fresh(), l, wv);
        GSYNC();
        { pg8::Gemm g{CK, (const bf16_t*)(ws + WS_WT_UKV) + (size_t)l * 2048 * 512, T, 2048, 512}; pg8::StaticOrder S; S.init(T, 2048, G, (int)blockIdx.x);
          pg8::EpiKV E{Kb, KV, kp_fresh()->k_nope_norm + l * 128, (PG8_LAS float*)(llds + pg8::STAGE_BYTES + 16)}; pg8::gemm_phase(llds, g, S, E, wv); }
        { pg8::Gemm g{(const bf16_t*)(ws + WS_PB) + (size_t)l * T * 256, (const bf16_t*)(ws + WS_WT_PP) + (size_t)l * 2048 * 256, T, 2048, 256}; pg8::StaticOrder S; S.init(T, 2048, G, (int)blockIdx.x);
          pg8::EpiBf16Store E{PPb, 2048}; pg8::gemm_phase(llds, g, S, E, wv); }
        GSYNC();
        phase_attn(kp_fresh(), (char*)lds, wv);
        GSYNC();
        { pg8::Gemm g{Y, (const bf16_t*)(ws + WS_WT_OUT) + (size_t)l * 2048 * 2048, T, 2048, 2048}; pg8::StaticOrder S; S.init(T, 2048, G, (int)blockIdx.x);
          pg8::EpiResMid E{hin, kp_fresh()->out, (const float*)(ws + WS_SSQA), (const float*)(ws + WS_SSQC), (bf16_t*)(ws + WS_KV), (float*)(ws + WS_SSQ2)};   pg8::gemm_phase(llds, g, S, E, wv); }
        GSYNC();
        { pg8::Gemm g{(const bf16_t*)(ws + WS_KV), (const bf16_t*)(ws + WS_WT_G) + (size_t)l * 2048 * 2048, T, 2048, 2048}; pg8::StaticOrder S; S.init(T, 2048, G, (int)blockIdx.x);
          pg8::EpiGate E{kp_fresh()->out, PPb, (const float*)(ws + WS_SSQ2)}; pg8::gemm_phase(llds, g, S, E, wv); }
        if (l + 1 < DEPTH) GSYNC();
    }
}

extern "C" void kernel_launch(void* const* d_in, const int* in_sizes, int n_in, void* d_out, int out_size, void* d_ws, size_t ws_size, hipStream_t stream) {
    static int grid_blocks = 0;
    if (grid_blocks == 0) {
        if (n_in != 21 || out_size != T * D_MODEL || ws_size < WS_END) { fprintf(stderr, "kernel_launch: unexpected shapes (n_in %d, out %d, ws %zu need %zu)\n", n_in, out_size, ws_size, (size_t)WS_END); grid_blocks = -1; return; }
        int dev = 0, cus = 0, per_cu = 0;
        hipGetDevice(&dev); hipDeviceGetAttribute(&cus, hipDeviceAttributeMultiprocessorCount, dev);
        if (hipFuncSetAttribute((const void*)fwd_megakernel, hipFuncAttributeMaxDynamicSharedMemorySize, LDS_BYTES) != hipSuccess) { fprintf(stderr, "kernel_launch: hipFuncSetAttribute failed\n"); grid_blocks = -1; return; }
        hipOccupancyMaxActiveBlocksPerMultiprocessor(&per_cu, (const void*)fwd_megakernel, NTHR, LDS_BYTES);
        if (per_cu < 1) { fprintf(stderr, "kernel_launch: occupancy query says %d blocks per CU\n", per_cu); per_cu = 1; }
        if (per_cu > 1) per_cu = 1;
        grid_blocks = cus * per_cu;
    }
    if (grid_blocks < 0) return;
    Params P{};
    P.x = (const float*)d_in[0]; P.p = (const float*)d_in[1]; P.positions = (const int*)d_in[2]; P.attn_norm = (const float*)d_in[3]; P.w_in = (const float*)d_in[4];
    P.sgu_norm = (const float*)d_in[5]; P.w_spatial = (const float*)d_in[6]; P.b_spatial = (const float*)d_in[7]; P.conv_w = (const float*)d_in[8]; P.conv_b = (const float*)d_in[9];
    P.kv_norm = (const float*)d_in[10]; P.w_ukv = (const float*)d_in[11]; P.q_nope_norm = (const float*)d_in[12]; P.q_rope_norm = (const float*)d_in[13];
    P.k_nope_norm = (const float*)d_in[14]; P.k_rope_norm = (const float*)d_in[15]; P.out_norm = (const float*)d_in[16]; P.w_out = (const float*)d_in[17];
    P.ple_norm = (const float*)d_in[18]; P.w_ple_gate = (const float*)d_in[19]; P.w_ple_proj = (const float*)d_in[20]; P.out = (float*)d_out; P.ws = (unsigned char*)d_ws;
    if (hipMemsetAsync((unsigned char*)d_ws + WS_BAR, 0, 16384, stream) != hipSuccess) { fprintf(stderr, "kernel_launch: memset failed\n"); return; }
    void* args[] = {&P};
    hipError_t e = hipLaunchCooperativeKernel((const void*)fwd_megakernel, dim3(grid_blocks), dim3(NTHR), args, LDS_BYTES, stream);
    if (e != hipSuccess) fprintf(stderr, "kernel_launch: cooperative launch failed: %s (grid %d)\n", hipGetErrorString(e), grid_blocks);
}
```

```cpp
#include <hip/hip_runtime.h>
#include <hip/hip_cooperative_groups.h>
#include <cstdio>
#include <cstdint>
namespace cg = cooperative_groups;

constexpr int D_MODEL = 2048, BATCH = 2, SEQ = 8192, DEPTH = 4, T = BATCH * SEQ;
constexpr int PLE = 256, IN_W = 6720, LDP = 6912  ;
constexpr int OFF_AU = 0, OFF_AV = 512, OFF_AZ = 1024, OFF_BB = 1536, OFF_BC = 2048, OFF_BH = 2560, OFF_BZ = 3072,
              OFF_CQ = 3584, OFF_CKV = 5120, OFF_CKR = 5632, OFF_CZ = 5696;
constexpr float EPS = 1e-6f;
constexpr int NTHR = 512;
constexpr int YC = 0, YA = 1024, YB = 1536;

typedef unsigned short bf16_t;
typedef short bf16x8 __attribute__((ext_vector_type(8)));
typedef short s16x4 __attribute__((ext_vector_type(4)));
typedef float f32x4 __attribute__((ext_vector_type(4)));
typedef float f32x16 __attribute__((ext_vector_type(16)));
typedef unsigned u32x4 __attribute__((ext_vector_type(4)));
typedef unsigned u32x2 __attribute__((ext_vector_type(2)));

constexpr size_t SZ_WT_IN = (size_t)DEPTH * LDP * 2048 * 2, SZ_WT_UKV = (size_t)DEPTH * 2048 * 512 * 2, SZ_WT_SQ = (size_t)DEPTH * 2048 * 2048 * 2,
                 SZ_WT_PP = (size_t)DEPTH * 2048 * 256 * 2, SZ_PB = (size_t)DEPTH * T * 256 * 2, SZ_ACT = (size_t)T * 2048 * 2,
                 SZ_PROJ = (size_t)T * LDP * 2, SZ_CKVN = (size_t)T * 512 * 2, SZ_QK = (size_t)BATCH * 8 * SEQ * 192 * 2, SZ_ROPE = (size_t)T * 32 * 4;
constexpr size_t WS_WT_IN = 0, WS_WT_UKV = WS_WT_IN + SZ_WT_IN, WS_WT_OUT = WS_WT_UKV + SZ_WT_UKV, WS_WT_G = WS_WT_OUT + SZ_WT_SQ,
                 WS_WT_PP = WS_WT_G + SZ_WT_SQ, WS_PB = WS_WT_PP + SZ_WT_PP, WS_Y = WS_PB + SZ_PB  , WS_PROJ = WS_Y + SZ_ACT,
                 WS_PP = WS_PROJ + SZ_PROJ, WS_CKVN = WS_PP + SZ_ACT, WS_KV = WS_CKVN + SZ_CKVN, WS_Q = WS_KV + SZ_ACT, WS_K = WS_Q + SZ_QK,
                 WS_COS = WS_K + SZ_QK, WS_SIN = WS_COS + SZ_ROPE, WS_BAR = WS_SIN + SZ_ROPE, WS_SSQA = WS_BAR + 16384, WS_SSQC = WS_SSQA + (size_t)T * 4 * 4, WS_SSQ2 = WS_SSQC + (size_t)T * 8 * 4, WS_H2 = WS_SSQ2 + (size_t)T * 32 * 4, WS_END = WS_H2 + SZ_ACT;

struct Params {
    const float* x; const float* p; const int* positions; const float* attn_norm; const float* w_in; const float* sgu_norm; const float* w_spatial;
    const float* b_spatial; const float* conv_w; const float* conv_b; const float* kv_norm; const float* w_ukv; const float* q_nope_norm;
    const float* q_rope_norm; const float* k_nope_norm; const float* k_rope_norm; const float* out_norm; const float* w_out; const float* ple_norm;
    const float* w_ple_gate; const float* w_ple_proj; float* out; unsigned char* ws;
};

typedef const __attribute__((address_space(4))) Params* KPtr;
__device__ __forceinline__ KPtr kp_fresh() { KPtr k = (KPtr)__builtin_amdgcn_kernarg_segment_ptr(); asm volatile("" : "+s"(k)); return k; }
__device__ __forceinline__ int otid(int wv) { unsigned z = 0u; asm volatile("" : "+v"(z)); return (int)__builtin_amdgcn_mbcnt_hi(~0u, __builtin_amdgcn_mbcnt_lo(~0u, z)) + 64 * wv; }
__device__ __forceinline__ float bf2f(bf16_t u) { return __uint_as_float(((unsigned)u) << 16); }
__device__ __forceinline__ float bflo(unsigned w) { return __uint_as_float(w << 16); }
__device__ __forceinline__ float bfhi(unsigned w) { return __uint_as_float(w & 0xffff0000u); }
__device__ __forceinline__ unsigned cvt_pk_bf16(float lo, float hi) { unsigned r; asm volatile("v_cvt_pk_bf16_f32 %0, %1, %2" : "=v"(r) : "v"(lo), "v"(hi)); return r; }
__device__ __forceinline__ bf16_t f2bf(float f) { return (bf16_t)(cvt_pk_bf16(f, 0.f) & 0xffffu); }
__device__ __forceinline__ float wave_sum(float v) { v += __shfl_xor(v, 32); v += __shfl_xor(v, 16); v += __shfl_xor(v, 8); v += __shfl_xor(v, 4); v += __shfl_xor(v, 2); v += __shfl_xor(v, 1); return v; }
__device__ __forceinline__ float sum8(float v) { v += __shfl_xor(v, 4); v += __shfl_xor(v, 2); v += __shfl_xor(v, 1); return v; }
__device__ __forceinline__ float silu(float z) { return z / (1.f + __expf(-z)); }
__device__ __forceinline__ float sigmoidf(float z) { return 1.f / (1.f + __expf(-z)); }
__device__ __forceinline__ void unpack8(u32x4 w, float* f) { f[0] = bflo(w.x); f[1] = bfhi(w.x); f[2] = bflo(w.y); f[3] = bfhi(w.y); f[4] = bflo(w.z); f[5] = bfhi(w.z); f[6] = bflo(w.w); f[7] = bfhi(w.w); }
__device__ __forceinline__ u32x4 pack8(const float* f) { u32x4 w; w.x = cvt_pk_bf16(f[0], f[1]); w.y = cvt_pk_bf16(f[2], f[3]); w.z = cvt_pk_bf16(f[4], f[5]); w.w = cvt_pk_bf16(f[6], f[7]); return w; }

namespace pg8 {
#define PG8_LAS __attribute__((address_space(3)))
constexpr int BM = 256, BK = 64, HALF = 128, HTB = HALF * BK * 2, STAGE_BYTES = 8 * HTB, NXCD = 8, WGM = 8;
__host__ __device__ __forceinline__ int lds_byte(int r, int c) { const int st = (r >> 4) * 2 + (c >> 5), rr = r & 15, cc = c & 31, ob = rr * 64 + cc * 2; return st * 1024 + (ob ^ (((ob >> 9) & 1) << 5)); }
__host__ __device__ __forceinline__ void stage_rc(int b, int& R, int& C) { const int st = b / 1024, sb = b % 1024, swz = sb ^ (((sb >> 9) & 1) << 5); R = (st >> 1) * 16 + swz / 64; C = (st & 1) * 32 + (swz % 64) / 2; }
__host__ __device__ __forceinline__ int perm32(int rho) { const int n = rho >> 4, i = rho & 15; return 8 * (i >> 2) + 4 * n + (i & 3); }
struct Unit { int pm, pn; };
struct Gemm { const bf16_t* A; const bf16_t* Bt; int M, N, K; };
struct StaticOrder {
    int nM, nN, nwg, G, c;
    __device__ void init(int M, int N, int G_, int c_) { nM = M / BM; nN = N / BM; nwg = nM * nN; G = G_; c = c_; }
    __device__ bool next(int i, Unit& u) const {
        const long L = (long)i * G + c; if (L >= nwg) return false;
        int wgid = (int)L; { const int q = nwg / NXCD, r = nwg % NXCD, xcd = wgid % NXCD, off = wgid / NXCD; wgid = (xcd < r ? xcd * (q + 1) : r * (q + 1) + (xcd - r) * q) + off; }
        const int nig = WGM * nN, gid = wgid / nig, fm = gid * WGM, gsz = (nM - fm) < WGM ? (nM - fm) : WGM;
        u.pm = fm + ((wgid % nig) % gsz); u.pn = (wgid % nig) / gsz; return true;
    }
};
template <class Epi>
__device__ __forceinline__ void gemm_phase(PG8_LAS unsigned char* lds, const Gemm g, const StaticOrder& S, const Epi& E, int wv) {
    const int tid = otid(wv), wid = __builtin_amdgcn_readfirstlane(tid >> 6), lane = tid & 63, wr = wid >> 2, wc = wid & 3, fr = lane & 15, fq = lane >> 4;
    const int K = g.K, nt = K / BK;
    unsigned voffA[2], voffB[2];
#pragma unroll
    for (int i = 0; i < 2; ++i) { int R, C; stage_rc(tid * 16 + i * 8192, R, C); const int Rb = Epi::PERM ? ((R & ~31) + perm32(R & 31)) : R;
        voffA[i] = (unsigned)(R * K + C) * 2u; voffB[i] = (unsigned)(Rb * K + C) * 2u; }
    const size_t kstep = (size_t)(BK * 2);
    const size_t hstep = (size_t)HALF * K * 2;
    const size_t tstep = 2 * hstep;
    const unsigned ldsw = (unsigned)wid * 1024u;
    const int aoff = lds_byte(wr * 64 + fr, fq * 8), boff = lds_byte(wc * 32 + fr, fq * 8);
#define PG8_SA(b, h) (((b) * 2 + (h)) * HTB)
#define PG8_SB(b, h) ((4 + (b) * 2 + (h)) * HTB)
#define PG8_STAGE(bufoff, gbase, voff) do { _Pragma("unroll") for (int _i = 0; _i < 2; ++_i) \
        __builtin_amdgcn_global_load_lds((const unsigned*)((const char*)(gbase) + (voff)[_i]), (PG8_LAS unsigned*)(lds + (bufoff) + ldsw + _i * 8192), 16, 0, 0); } while (0)
#define PG8_LDA(dst, b, h) do { _Pragma("unroll") for (int m = 0; m < 4; ++m) _Pragma("unroll") for (int k = 0; k < 2; ++k) dst[m][k] = *(const PG8_LAS bf16x8*)(lds + PG8_SA(b, h) + aoff + m * 2048 + k * 1024); } while (0)
#define PG8_LDB(dst, b, h) do { _Pragma("unroll") for (int n = 0; n < 2; ++n) _Pragma("unroll") for (int k = 0; k < 2; ++k) dst[n][k] = *(const PG8_LAS bf16x8*)(lds + PG8_SB(b, h) + boff + n * 2048 + k * 1024); } while (0)
#define PG8_MMA(ai, bj, At, Bt) do { __builtin_amdgcn_s_setprio(1); _Pragma("unroll") for (int m = 0; m < 4; ++m) _Pragma("unroll") for (int n = 0; n < 2; ++n) _Pragma("unroll") for (int k = 0; k < 2; ++k) \
        acc[ai][bj][m][n] = __builtin_amdgcn_mfma_f32_16x16x32_bf16(Bt[n][k], At[m][k], acc[ai][bj][m][n], 0, 0, 0); __builtin_amdgcn_s_setprio(0); } while (0)
#define PG8_WAIT_V(n) asm volatile("s_waitcnt vmcnt(" #n ")" ::: "memory")
#define PG8_WAIT_L(n) asm volatile("s_waitcnt lgkmcnt(" #n ")" ::: "memory")
#define PG8_BAR __builtin_amdgcn_s_barrier()
#define PG8_SCHED __builtin_amdgcn_sched_barrier(0)
    Unit cur, nxt; int ui = 0;
    if (!S.next(0, cur)) return;
    f32x4 acc[2][2][4][2];
#pragma unroll
    for (int a = 0; a < 2; ++a)
#pragma unroll
        for (int b = 0; b < 2; ++b)
#pragma unroll
            for (int m = 0; m < 4; ++m)
#pragma unroll
                for (int n = 0; n < 2; ++n) acc[a][b][m][n] = (f32x4){0.f, 0.f, 0.f, 0.f};
    bf16x8 At[4][2], B0[2][2], B1[2][2];
    float hk[8];
    const char* cA = (const char*)g.A + (size_t)cur.pm * tstep; const char* cB = (const char*)g.Bt + (size_t)cur.pn * tstep;
    PG8_STAGE(PG8_SB(0, 0), cB, voffB); PG8_STAGE(PG8_SA(0, 0), cA, voffA); PG8_STAGE(PG8_SB(0, 1), cB + hstep, voffB); PG8_STAGE(PG8_SA(0, 1), cA + hstep, voffA);
    if (wr == 1) PG8_BAR;
    PG8_WAIT_V(4); PG8_BAR;
    PG8_STAGE(PG8_SB(1, 0), cB + kstep, voffB); PG8_STAGE(PG8_SA(1, 0), cA + kstep, voffA); PG8_STAGE(PG8_SB(1, 1), cB + hstep + kstep, voffB);
    PG8_WAIT_V(6); PG8_BAR;
    for (;;) {
        const bool has_next = S.next(ui + 1, nxt);
        const char* nA = has_next ? (const char*)g.A + (size_t)nxt.pm * tstep : cA; const char* nB = has_next ? (const char*)g.Bt + (size_t)nxt.pn * tstep : cB;
        constexpr int NSEG = Epi::HOOKS ? 3 : 1;
#pragma unroll
        for (int seg = 0; seg < NSEG; ++seg) {
        int tb = 0, te = nt;
        if constexpr (Epi::HOOKS) { tb = (seg == 0) ? 0 : (seg == 1 ? Epi::T1 : Epi::T2); te = (seg == 0) ? Epi::T1 : (seg == 1 ? Epi::T2 : nt);
            if (seg == 1) { PG8_SCHED; E.hook1(acc, hk, cur, wr, lane); PG8_SCHED; } if (seg == 2) { PG8_SCHED; E.hook2(acc, hk); PG8_SCHED; } }
        for (int t = tb; t < te; t += 2) {
            const bool last = (t == nt - 2);
            const char* a1 = cA + (size_t)(t + 1) * kstep;
            const char* a2 = last ? nA : cA + (size_t)(t + 2) * kstep; const char* b2 = last ? nB : cB + (size_t)(t + 2) * kstep;
            const char* a3 = a2 + kstep; const char* b3 = b2 + kstep;
            PG8_LDB(B0, 0, 0); PG8_SCHED; PG8_LDA(At, 0, 0); PG8_STAGE(PG8_SA(1, 1), a1 + hstep, voffA);
            PG8_WAIT_L(8); PG8_BAR; PG8_WAIT_L(0); PG8_MMA(0, 0, At, B0); PG8_BAR; PG8_SCHED;
            PG8_LDB(B1, 0, 1); PG8_STAGE(PG8_SB(0, 0), b2, voffB);
            PG8_BAR; PG8_WAIT_L(0); PG8_MMA(0, 1, At, B1); PG8_BAR;
            PG8_LDA(At, 0, 1); PG8_STAGE(PG8_SA(0, 0), a2, voffA);
            PG8_BAR; PG8_WAIT_L(0); PG8_MMA(1, 0, At, B0); PG8_BAR; PG8_SCHED;
            PG8_STAGE(PG8_SB(0, 1), b2 + hstep, voffB);
            PG8_WAIT_V(6); PG8_BAR; PG8_MMA(1, 1, At, B1); PG8_BAR;
            PG8_LDB(B0, 1, 0); PG8_SCHED; PG8_LDA(At, 1, 0); PG8_STAGE(PG8_SA(0, 1), a2 + hstep, voffA);
            PG8_WAIT_L(8); PG8_BAR; PG8_WAIT_L(0); PG8_MMA(0, 0, At, B0); PG8_BAR; PG8_SCHED;
            PG8_LDB(B1, 1, 1); PG8_STAGE(PG8_SB(1, 0), b3, voffB);
            PG8_BAR; PG8_WAIT_L(0); PG8_MMA(0, 1, At, B1); PG8_BAR;
            PG8_LDA(At, 1, 1); PG8_STAGE(PG8_SA(1, 0), a3, voffA);
            PG8_BAR; PG8_WAIT_L(0); PG8_MMA(1, 0, At, B0); PG8_BAR; PG8_SCHED;
            PG8_STAGE(PG8_SB(1, 1), b3 + hstep, voffB);
            PG8_WAIT_V(6); PG8_BAR; PG8_MMA(1, 1, At, B1); PG8_BAR;
        }
        }
        E(acc, cur, wr, wc, fr, fq);
        if (!has_next) break;
#pragma unroll
        for (int a = 0; a < 2; ++a)
#pragma unroll
            for (int b = 0; b < 2; ++b)
#pragma unroll
                for (int m = 0; m < 4; ++m)
#pragma unroll
                    for (int n = 0; n < 2; ++n) acc[a][b][m][n] = (f32x4){0.f, 0.f, 0.f, 0.f};
        cur = nxt; cA = nA; cB = nB; ++ui;
    }
    PG8_WAIT_V(0);
    if (wr == 0) PG8_BAR;
    PG8_BAR;
#undef PG8_SA
#undef PG8_SB
#undef PG8_STAGE
#undef PG8_LDA
#undef PG8_LDB
#undef PG8_MMA
#undef PG8_WAIT_V
#undef PG8_WAIT_L
#undef PG8_BAR
#undef PG8_SCHED
}

struct EpiBf16Store {
    static constexpr bool PERM = true; static constexpr bool HOOKS = false;
    bf16_t* O; int ldc;
    __device__ __forceinline__ void operator()(const f32x4 (&acc)[2][2][4][2], const Unit& u, int wr, int wc, int fr, int fq) const {
        const int row0 = u.pm * BM + wr * 64 + fr, col0 = u.pn * BM + wc * 32 + 8 * fq;
#pragma unroll
        for (int ai = 0; ai < 2; ++ai)
#pragma unroll
            for (int m = 0; m < 4; ++m) { bf16_t* rowp = O + (size_t)(row0 + ai * HALF + m * 16) * ldc + col0;
#pragma unroll
                for (int bj = 0; bj < 2; ++bj) { const f32x4 v0 = acc[ai][bj][m][0], v1 = acc[ai][bj][m][1];
                    u32x4 w; w.x = cvt_pk_bf16(v0[0], v0[1]); w.y = cvt_pk_bf16(v0[2], v0[3]); w.z = cvt_pk_bf16(v1[0], v1[1]); w.w = cvt_pk_bf16(v1[2], v1[3]);
                    *(u32x4*)(rowp + bj * HALF) = w; } }
    }
};
struct EpiResF32 {
    static constexpr bool PERM = false; static constexpr bool HOOKS = false;
    const float* in; float* out;
    __device__ __forceinline__ void operator()(const f32x4 (&acc)[2][2][4][2], const Unit& u, int wr, int wc, int fr, int fq) const {
        const int row0 = u.pm * BM + wr * 64 + fr, col0 = u.pn * BM + wc * 32 + 4 * fq;
#pragma unroll
        for (int ai = 0; ai < 2; ++ai)
#pragma unroll
            for (int m = 0; m < 4; ++m) { const size_t ro = (size_t)(row0 + ai * HALF + m * 16) * D_MODEL + col0;
#pragma unroll
                for (int bj = 0; bj < 2; ++bj)
#pragma unroll
                    for (int n = 0; n < 2; ++n) { const f32x4 r = *(const f32x4*)(in + ro + bj * HALF + n * 16); *(f32x4*)(out + ro + bj * HALF + n * 16) = r + acc[ai][bj][m][n]; } }
    }
};
template <bool LAST> struct EpiGate {
    static constexpr bool PERM = false; static constexpr bool HOOKS = false;
    const bf16_t* h1; const bf16_t* pp; const float* ssq_in; void* out;
    __device__ __forceinline__ void operator()(const f32x4 (&acc)[2][2][4][2], const Unit& u, int wr, int wc, int fr, int fq) const {
        int lx = fr | (fq << 4); asm volatile("" : "+v"(lx));
        const int frx = lx & 15, fqx = lx >> 4;
        const int row0 = u.pm * BM + wr * 64 + frx, col0 = u.pn * BM + wc * 32 + 4 * fqx;
#pragma unroll
        for (int ai = 0; ai < 2; ++ai) {
            float rs[4];
#pragma unroll
            for (int m = 0; m < 4; ++m) { const float* sp = ssq_in + ((row0 + ai * HALF + m * 16) * 32 + fqx * 8); const f32x4 a = *(const f32x4*)sp, b = *(const f32x4*)(sp + 4);
                float t = ((a[0] + a[1]) + (a[2] + a[3])) + ((b[0] + b[1]) + (b[2] + b[3])); t += __shfl_xor(t, 16); t += __shfl_xor(t, 32); rs[m] = rsqrtf(t * (1.f / 2048.f) + EPS); }
#pragma unroll
            for (int m = 0; m < 4; ++m) { const size_t ro = (size_t)(row0 + ai * HALF + m * 16) * D_MODEL + col0; const float rr = rs[m];
#pragma unroll
                for (int bj = 0; bj < 2; ++bj)
#pragma unroll
                    for (int n = 0; n < 2; ++n) { const size_t o = ro + bj * HALF + n * 16; const u32x2 hw = *(const u32x2*)(h1 + o); const u32x2 pw = *(const u32x2*)(pp + o);
                        const f32x4 a = acc[ai][bj][m][n] * rr; f32x4 v;
                        v[0] = bflo(hw.x) + sigmoidf(a[0]) * bflo(pw.x); v[1] = bfhi(hw.x) + sigmoidf(a[1]) * bfhi(pw.x); v[2] = bflo(hw.y) + sigmoidf(a[2]) * bflo(pw.y); v[3] = bfhi(hw.y) + sigmoidf(a[3]) * bfhi(pw.y);
                        if constexpr (LAST) *(f32x4*)((float*)out + o) = v;
                        else { u32x2 w; w.x = cvt_pk_bf16(v[0], v[1]); w.y = cvt_pk_bf16(v[2], v[3]); *(u32x2*)((bf16_t*)out + o) = w; } } } }
    }
};
struct EpiKV {
    static constexpr bool PERM = true; static constexpr bool HOOKS = false;
    bf16_t* Kb; bf16_t* KV; const float* kn_g; PG8_LAS float* xl;
    __device__ __forceinline__ void operator()(const f32x4 (&acc)[2][2][4][2], const Unit& u, int wr, int wc, int fr, int fq) const {
        const int rl0 = wr * 64 + fr, c0 = wc * 32 + 8 * fq, h = u.pn;
#pragma unroll
        for (int ai = 0; ai < 2; ++ai)
#pragma unroll
            for (int m = 0; m < 4; ++m) { const f32x4 a = acc[ai][0][m][0], b = acc[ai][0][m][1];
                float s = (a[0] * a[0] + a[1] * a[1]) + (a[2] * a[2] + a[3] * a[3]) + (b[0] * b[0] + b[1] * b[1]) + (b[2] * b[2] + b[3] * b[3]);
                s += __shfl_xor(s, 16); s += __shfl_xor(s, 32);
                if (fq == 0) xl[(ai * HALF + rl0 + m * 16) * 4 + wc] = s; }
        asm volatile("s_waitcnt lgkmcnt(0)" ::: "memory"); __builtin_amdgcn_s_barrier(); asm volatile("" ::: "memory");
        float g[8];
        { const f32x4 g0 = *(const f32x4*)(kn_g + c0), g1 = *(const f32x4*)(kn_g + c0 + 4);
#pragma unroll
          for (int j = 0; j < 4; ++j) { g[j] = g0[j]; g[4 + j] = g1[j]; } }
#pragma unroll
        for (int ai = 0; ai < 2; ++ai)
#pragma unroll
            for (int m = 0; m < 4; ++m) { const int rl = ai * HALF + rl0 + m * 16; const f32x4 p = *(const PG8_LAS f32x4*)(xl + rl * 4);
                const float rs = rsqrtf(((p[0] + p[1]) + (p[2] + p[3])) * (1.f / 128.f) + EPS);
                const int t = u.pm * BM + rl, b = t / SEQ, sq = t - b * SEQ;
                const f32x4 k0 = acc[ai][0][m][0] * rs, k1 = acc[ai][0][m][1] * rs, v0 = acc[ai][1][m][0], v1 = acc[ai][1][m][1];
                u32x4 w; w.x = cvt_pk_bf16(k0[0] * g[0], k0[1] * g[1]); w.y = cvt_pk_bf16(k0[2] * g[2], k0[3] * g[3]); w.z = cvt_pk_bf16(k1[0] * g[4], k1[1] * g[5]); w.w = cvt_pk_bf16(k1[2] * g[6], k1[3] * g[7]);
                *(u32x4*)(Kb + ((size_t)(b * 8 + h) * SEQ + sq) * 192 + c0) = w;
                u32x4 x; x.x = cvt_pk_bf16(v0[0], v0[1]); x.y = cvt_pk_bf16(v0[2], v0[3]); x.z = cvt_pk_bf16(v1[0], v1[1]); x.w = cvt_pk_bf16(v1[2], v1[3]);
                *(u32x4*)(KV + (size_t)t * 2048 + h * 256 + 128 + c0) = x; }
    }
};
template <bool IN_BF16> struct EpiResMid {
    static constexpr bool PERM = false; static constexpr bool HOOKS = true; static constexpr int T1 = 16, T2 = 24;
    const void* in; const float* ssqa; const float* ssqc;
    bf16_t* hb; float* ssq2;
    __device__ __forceinline__ void hook1(f32x4 (&acc)[2][2][4][2], float (&hk)[8], const Unit& u, int wr, int fr) const {
        int frx = fr; asm volatile("" : "+v"(frx));
        const int row0 = u.pm * BM + wr * 64 + (frx & 15), fq = (frx >> 4) & 3;
        typedef float f32x2 __attribute__((ext_vector_type(2)));
#pragma unroll
        for (int ai = 0; ai < 2; ++ai) {
            float cs[4], as_[4];
#pragma unroll
            for (int m = 0; m < 4; ++m) { const int row = row0 + ai * HALF + m * 16; const f32x2 c = *(const f32x2*)(ssqc + (row * 8 + fq * 2)); cs[m] = c.x + c.y; as_[m] = ssqa[row * 4 + fq]; }
#pragma unroll
            for (int m = 0; m < 4; ++m) { cs[m] += __shfl_xor(cs[m], 16); cs[m] += __shfl_xor(cs[m], 32); as_[m] += __shfl_xor(as_[m], 16); as_[m] += __shfl_xor(as_[m], 32); }
#pragma unroll
            for (int m = 0; m < 4; ++m) {
                const float rsC = rsqrtf(cs[m] * (1.f / 1024.f) + EPS); const float sA = as_[m] * (1.f / 512.f) + EPS; const float rsA = rsqrtf(sA);
                hk[ai * 4 + m] = rsA; const float f = rsC * sA * rsA;
#pragma unroll
                for (int bj = 0; bj < 2; ++bj)
#pragma unroll
                    for (int n = 0; n < 2; ++n) acc[ai][bj][m][n] = acc[ai][bj][m][n] * f; }
            __builtin_amdgcn_sched_barrier(0);
        }
    }
    __device__ __forceinline__ void hook2(f32x4 (&acc)[2][2][4][2], const float (&hk)[8]) const {
#pragma unroll
        for (int ai = 0; ai < 2; ++ai)
#pragma unroll
            for (int m = 0; m < 4; ++m)
#pragma unroll
                for (int bj = 0; bj < 2; ++bj)
#pragma unroll
                    for (int n = 0; n < 2; ++n) acc[ai][bj][m][n] = acc[ai][bj][m][n] * hk[ai * 4 + m];
    }
    __device__ __forceinline__ void operator()(const f32x4 (&acc)[2][2][4][2], const Unit& u, int wr, int wc, int fr, int fq) const {
        const int row0 = u.pm * BM + wr * 64 + fr, col0 = u.pn * BM + wc * 32 + 4 * fq;
#pragma unroll
        for (int ai = 0; ai < 2; ++ai)
#pragma unroll
            for (int m = 0; m < 4; ++m) { const int row = row0 + ai * HALF + m * 16; const size_t ro = (size_t)row * D_MODEL + col0; float ss = 0.f;
#pragma unroll
                for (int bj = 0; bj < 2; ++bj)
#pragma unroll
                    for (int n = 0; n < 2; ++n) { const size_t o = ro + bj * HALF + n * 16; f32x4 r;
                        if constexpr (IN_BF16) { const u32x2 w = *(const u32x2*)((const bf16_t*)in + o); r = (f32x4){bflo(w.x), bfhi(w.x), bflo(w.y), bfhi(w.y)}; }
                        else r = *(const f32x4*)((const float*)in + o);
                        const f32x4 v = r + acc[ai][bj][m][n];
                        u32x2 w; w.x = cvt_pk_bf16(v[0], v[1]); w.y = cvt_pk_bf16(v[2], v[3]); *(u32x2*)(hb + o) = w; ss += (v[0] * v[0] + v[1] * v[1]) + (v[2] * v[2] + v[3] * v[3]); }
                ss += __shfl_xor(ss, 16); ss += __shfl_xor(ss, 32);
                if (fq == 0) ssq2[row * 32 + u.pn * 4 + wc] = ss; }
    }
};
}


#define XB_TMO      128
#define XB_XCNT(j)  (256  + 64 * (j))
#define XB_XSUB(j)  (1280 + 64 * (j))
#define XB_XGEN(j)  (2304 + 64 * (j))
#define XB_TOP      3328
#define XB_TOPGEN   3392
#define XCD_BAR_WORDS 3456
#define XB_SPIN_CAP (1u << 22)
__device__ __forceinline__ unsigned xb_ld(unsigned* p)              { return __hip_atomic_load(p, __ATOMIC_RELAXED, __HIP_MEMORY_SCOPE_AGENT); }
__device__ __forceinline__ unsigned xb_add(unsigned* p, unsigned v) { return __hip_atomic_fetch_add(p, v, __ATOMIC_RELAXED, __HIP_MEMORY_SCOPE_AGENT); }
__device__ __forceinline__ unsigned xb_xcc_id() { return (unsigned)__builtin_amdgcn_s_getreg((3 << 11) | 20) & 0xFu; }
#define XB_SPIN(cond, bar) do { unsigned _sp = 0; while (cond) { __builtin_amdgcn_s_sleep(1); \
    if ((++_sp & 255u) == 0u) { if (xb_ld(&(bar)[XB_TMO])) break; if (_sp > XB_SPIN_CAP) { atomicAdd(&(bar)[XB_TMO], 1u); break; } } } } while (0)
struct XcdBarrier { unsigned* bar; unsigned x; volatile PG8_LAS unsigned* st; };
__device__ __forceinline__ XcdBarrier xcd_barrier_post(unsigned* bar, volatile PG8_LAS unsigned* st, int wv) {
    XcdBarrier b; b.bar = bar; b.x = xb_xcc_id(); b.st = st;
    if (otid(wv) == 0) (void)xb_add(&bar[XB_XCNT(b.x)], 1u);
    return b;
}
__device__ __forceinline__ void xcd_barrier_complete(unsigned* bar, unsigned x, unsigned& nloc, unsigned& nx) {
    const unsigned G = gridDim.x * gridDim.y * gridDim.z;
    unsigned sum, cnt, mine, sp = 0u;
    for (;;) {
        sum = 0u; cnt = 0u; mine = 0u;
#pragma unroll
        for (unsigned j = 0; j < 16; ++j) { const unsigned c = xb_ld(&bar[XB_XCNT(j)]); sum += c; cnt += (c > 0u) ? 1u : 0u; mine = (j == x) ? c : mine; }
        if (sum == G) break;
        __builtin_amdgcn_s_sleep(1);
        if ((++sp & 255u) == 0u) { if (xb_ld(&bar[XB_TMO])) break; if (sp > XB_SPIN_CAP) { atomicAdd(&bar[XB_TMO], 1u); break; } }
    }
    nloc = mine > 0u ? mine : 1u; nx = cnt > 0u ? cnt : 1u;
}
__device__ __forceinline__ void xcd_barrier(const XcdBarrier& b, int wv) {
    asm volatile("s_waitcnt vmcnt(0)" ::: "memory");
    __syncthreads();
    if (otid(wv) == 0) {
        unsigned* bar = b.bar;
        __builtin_amdgcn_s_waitcnt(0);
        unsigned nloc = b.st[0], nx = b.st[1];
        if (nloc == 0u) { xcd_barrier_complete(bar, b.x, nloc, nx); b.st[0] = nloc; b.st[1] = nx; }
        const unsigned old = xb_add(&bar[XB_XSUB(b.x)], 1u);
        const unsigned gen = old / nloc;
        if (old + 1u == (gen + 1u) * nloc) {
            __builtin_amdgcn_fence(__ATOMIC_RELEASE, "agent");
            asm volatile("s_waitcnt vmcnt(0)" ::: "memory");
            const unsigned og = xb_add(&bar[XB_TOP], 1u);
            const unsigned tg = og / nx;
            if (og + 1u == (tg + 1u) * nx) xb_add(&bar[XB_TOPGEN], 1u);
            else XB_SPIN(xb_ld(&bar[XB_TOPGEN]) == tg, bar);
            __builtin_amdgcn_fence(__ATOMIC_ACQUIRE, "agent");
            xb_add(&bar[XB_XGEN(b.x)], 1u);
            asm volatile("s_waitcnt vmcnt(0)" ::: "memory");
        } else {
            XB_SPIN(xb_ld(&bar[XB_XGEN(b.x)]) == gen, bar);
            __builtin_amdgcn_fence(__ATOMIC_ACQUIRE, "agent");
            asm volatile("s_waitcnt vmcnt(0)" ::: "memory");
        }
    }
    __syncthreads();
}

namespace att {
constexpr int QPARK_OFF = 8 * 128 * 64 * 2 + 16 + 4096;
constexpr int DQ = 192, NW = 8, QBLK = 32, KVBLK = 64;
constexpr float SCALE = 0.07216878364870322f;
constexpr float THR = 8.f;
constexpr int LDQ = 192, LDK = 192, LDV = 2048;
constexpr int SHM_V = KVBLK * 128 * 2, SHM_K = KVBLK * DQ * 2, OFF_K = 3 * SHM_V, OFF_W = OFF_K + 3 * SHM_K, SHM_ATTN = OFF_W + NW * 64 * 4, NQREG = 12, SHM_QPARK = (12 - NQREG) * 512 * 16;
#define KSWZ(row, colB) ((row) * 384 + ((colB) ^ ((((row) >> 1) & 7) << 4)))
#define SBAR() __builtin_amdgcn_sched_barrier(0)
__device__ __forceinline__ int crow(int r, int hi) { return (r & 3) + 8 * (r >> 2) + 4 * hi; }
__device__ __forceinline__ void partialSM(f32x16& p0, f32x16& p1, float& m_reg, float& mn, float& alpha) {
    constexpr float C = SCALE * 1.4426950408889634f;
    float pmax = p0[0];
#pragma unroll
    for (int r = 1; r < 16; ++r) pmax = fmaxf(pmax, p0[r]);
#pragma unroll
    for (int r = 0; r < 16; ++r) pmax = fmaxf(pmax, p1[r]);
    { auto rr = __builtin_amdgcn_permlane32_swap(__float_as_uint(pmax), __float_as_uint(pmax), false, false);
      pmax = fmaxf(__uint_as_float(rr[0]), __uint_as_float(rr[1])); }
    if (__builtin_expect(__all(pmax - m_reg <= THR / SCALE), 1)) { mn = m_reg; alpha = 1.f; }
    else { mn = fmaxf(m_reg, pmax); alpha = __builtin_amdgcn_exp2f((m_reg - mn) * C); m_reg = mn; }
    float mnC = -mn * C;
#pragma unroll
    for (int r = 0; r < 16; ++r) p0[r] = fmaf(p0[r], C, mnC);
#pragma unroll
    for (int r = 0; r < 16; ++r) p1[r] = fmaf(p1[r], C, mnC);
#pragma unroll
    for (int r = 0; r < 16; ++r) p0[r] = __builtin_amdgcn_exp2f(p0[r]);
}
__device__ __forceinline__ void finishSM(f32x16& p0, f32x16& p1, float alpha, float& l_reg, bf16x8& pa0, bf16x8& pa1, bf16x8& pa2, bf16x8& pa3) {
#pragma unroll
    for (int r = 0; r < 16; ++r) p1[r] = __builtin_amdgcn_exp2f(p1[r]);
    float ps = 0;
#pragma unroll
    for (int r = 0; r < 16; ++r) ps += p0[r];
#pragma unroll
    for (int r = 0; r < 16; ++r) ps += p1[r];
    { auto rr = __builtin_amdgcn_permlane32_swap(__float_as_uint(ps), __float_as_uint(ps), false, false);
      ps = __uint_as_float(rr[0]) + __uint_as_float(rr[1]); }
    l_reg = l_reg * alpha + ps;
#define PK4(P, BASE, OUT) do { unsigned a0 = cvt_pk_bf16(P[BASE + 0], P[BASE + 1]), a1 = cvt_pk_bf16(P[BASE + 2], P[BASE + 3]);   \
    unsigned b0 = cvt_pk_bf16(P[BASE + 4], P[BASE + 5]), b1 = cvt_pk_bf16(P[BASE + 6], P[BASE + 7]);                              \
    auto r0 = __builtin_amdgcn_permlane32_swap(a0, b0, false, false); auto r1 = __builtin_amdgcn_permlane32_swap(a1, b1, false, false); \
    u32x4 w = {r0[0], r1[0], r0[1], r1[1]}; OUT = *reinterpret_cast<bf16x8*>(&w); } while (0)
    PK4(p0, 0, pa0); PK4(p0, 8, pa1); PK4(p1, 0, pa2); PK4(p1, 8, pa3);
#undef PK4
}
template <int OFF> __device__ __forceinline__ bf16x8 k_read(int a) { bf16x8 r; asm volatile("ds_read_b128 %0, %1 offset:%2" : "=&v"(r) : "v"(a), "i"(OFF) : "memory"); return r; }
constexpr int KDEPTH = 3;
template <int D0> __device__ __forceinline__ void k_pair(bf16x8& b0, bf16x8& b1, const int* ka) { b0 = k_read<(D0 >> 2) * 128>(ka[D0 & 3]); b1 = k_read<(D0 >> 2) * 128 + 32 * 384>(ka[D0 & 3]); }
template <int N> __device__ __forceinline__ void lgkm_wait(bf16x8& a, bf16x8& b) { asm volatile("s_waitcnt lgkmcnt(%2)" : "+v"(a), "+v"(b) : "n"(N) : "memory"); }
template <int D0> __device__ __forceinline__ void qkt_step(f32x16& p0, f32x16& p1, const bf16x8* qr, const int* ka, bf16x8 (&f0)[4], bf16x8 (&f1)[4]) {
    if constexpr (D0 + KDEPTH < 12) k_pair<D0 + KDEPTH>(f0[(D0 + KDEPTH) & 3], f1[(D0 + KDEPTH) & 3], ka);
    constexpr int younger = ((11 - D0) < KDEPTH ? (11 - D0) : KDEPTH) * 2;
    lgkm_wait<younger>(f0[D0 & 3], f1[D0 & 3]);
    p0 = __builtin_amdgcn_mfma_f32_32x32x16_bf16(f0[D0 & 3], qr[D0], p0, 0, 0, 0);
    p1 = __builtin_amdgcn_mfma_f32_32x32x16_bf16(f1[D0 & 3], qr[D0], p1, 0, 0, 0);
}
__device__ __forceinline__ void qkt(f32x16& p0, f32x16& p1, int kbase, const bf16x8* qr, const int* ko, const char*  ) {
    p0 = f32x16{}; p1 = f32x16{};
    int ka[4];
#pragma unroll
    for (int e = 0; e < 4; ++e) ka[e] = kbase + ko[e];
    bf16x8 f0[4], f1[4];
    k_pair<0>(f0[0], f1[0], ka); k_pair<1>(f0[1], f1[1], ka); if constexpr (KDEPTH > 2) k_pair<2>(f0[2], f1[2], ka);
    qkt_step<0>(p0, p1, qr, ka, f0, f1); qkt_step<1>(p0, p1, qr, ka, f0, f1); qkt_step<2>(p0, p1, qr, ka, f0, f1); qkt_step<3>(p0, p1, qr, ka, f0, f1);
    qkt_step<4>(p0, p1, qr, ka, f0, f1); qkt_step<5>(p0, p1, qr, ka, f0, f1); qkt_step<6>(p0, p1, qr, ka, f0, f1); qkt_step<7>(p0, p1, qr, ka, f0, f1);
    qkt_step<8>(p0, p1, qr, ka, f0, f1); qkt_step<9>(p0, p1, qr, ka, f0, f1); qkt_step<10>(p0, p1, qr, ka, f0, f1); qkt_step<11>(p0, p1, qr, ka, f0, f1);
}
__device__ __forceinline__ int v_st(int k, int c) { const int kk = (k & ~0xC) | ((k & 4) << 1) | ((k & 8) >> 1); return ((kk >> 3) * 4 + (c >> 5)) * 512 + ((kk & 7) * 32 + (c & 31)) * 2; }
__device__ __forceinline__ int v_rd_base(int lane) { return ((lane & 3) << 3) | (((lane >> 2) & 3) << 6) | (((lane >> 4) & 1) << 5) | (((lane >> 5) & 1) << 8); }
constexpr int v_rd_off(int d0, int ks, int half) { return d0 * 512 + ks * 4096 + half * 2048; }
template <int OFF> __device__ __forceinline__ s16x4 tr_read(int vb) {
    s16x4 r; asm volatile("ds_read_b64_tr_b16 %0, %1 offset:%2" : "=&v"(r) : "v"(vb), "i"(OFF) : "memory"); return r;
}
struct VFrag { s16x4 l0, h0, l1, h1, l2, h2, l3, h3; };
template <int D0> __device__ __forceinline__ void v_read8(VFrag& f, int vb) {
    f.l0 = tr_read<v_rd_off(D0, 0, 0)>(vb); f.h0 = tr_read<v_rd_off(D0, 0, 1)>(vb); f.l1 = tr_read<v_rd_off(D0, 1, 0)>(vb); f.h1 = tr_read<v_rd_off(D0, 1, 1)>(vb);
    f.l2 = tr_read<v_rd_off(D0, 2, 0)>(vb); f.h2 = tr_read<v_rd_off(D0, 2, 1)>(vb); f.l3 = tr_read<v_rd_off(D0, 3, 0)>(vb); f.h3 = tr_read<v_rd_off(D0, 3, 1)>(vb);
}
__device__ __forceinline__ void pv_mma4(f32x16& od, const VFrag& f, bf16x8 pa0, bf16x8 pa1, bf16x8 pa2, bf16x8 pa3) {
#define PK(L, H) (bf16x8){L[0], L[1], L[2], L[3], H[0], H[1], H[2], H[3]}
    od = __builtin_amdgcn_mfma_f32_32x32x16_bf16(pa0, PK(f.l0, f.h0), od, 0, 0, 0);
    od = __builtin_amdgcn_mfma_f32_32x32x16_bf16(pa1, PK(f.l1, f.h1), od, 0, 0, 0);
    od = __builtin_amdgcn_mfma_f32_32x32x16_bf16(pa2, PK(f.l2, f.h2), od, 0, 0, 0);
    od = __builtin_amdgcn_mfma_f32_32x32x16_bf16(pa3, PK(f.l3, f.h3), od, 0, 0, 0);
#undef PK
}
__device__ __forceinline__ void pv_d0_1(f32x16* o, int vb, bf16x8 pa0, bf16x8 pa1, bf16x8 pa2, bf16x8 pa3) {
    VFrag f;
    v_read8<0>(f, vb); asm volatile("s_waitcnt lgkmcnt(0)" ::: "memory"); SBAR(); pv_mma4(o[0], f, pa0, pa1, pa2, pa3); SBAR();
    v_read8<1>(f, vb); asm volatile("s_waitcnt lgkmcnt(0)" ::: "memory"); SBAR(); pv_mma4(o[1], f, pa0, pa1, pa2, pa3); SBAR();
    v_read8<2>(f, vb); asm volatile("s_waitcnt lgkmcnt(0)" ::: "memory"); SBAR(); pv_mma4(o[2], f, pa0, pa1, pa2, pa3); SBAR();
    v_read8<3>(f, vb); asm volatile("s_waitcnt lgkmcnt(0)" ::: "memory"); SBAR(); pv_mma4(o[3], f, pa0, pa1, pa2, pa3);
}
__device__ __forceinline__ void pv_d0(f32x16* o, int vb, bf16x8 pa0, bf16x8 pa1, bf16x8 pa2, bf16x8 pa3) {
    VFrag fa, fb;
    v_read8<0>(fa, vb); v_read8<1>(fb, vb);
    asm volatile("s_waitcnt lgkmcnt(8)" ::: "memory"); SBAR(); pv_mma4(o[0], fa, pa0, pa1, pa2, pa3); SBAR();
    v_read8<2>(fa, vb);
    asm volatile("s_waitcnt lgkmcnt(8)" ::: "memory"); SBAR(); pv_mma4(o[1], fb, pa0, pa1, pa2, pa3); SBAR();
    v_read8<3>(fb, vb);
    asm volatile("s_waitcnt lgkmcnt(8)" ::: "memory"); SBAR(); pv_mma4(o[2], fa, pa0, pa1, pa2, pa3); SBAR();
    asm volatile("s_waitcnt lgkmcnt(0)" ::: "memory"); SBAR(); pv_mma4(o[3], fb, pa0, pa1, pa2, pa3);
}
__device__ __forceinline__ void attn_body(const bf16_t* __restrict__ Qb, const bf16_t* __restrict__ Kh, const bf16_t* __restrict__ Vh,
                                          const bf16_t* __restrict__ Zb, bf16_t* __restrict__ Yb, float* __restrict__ Sq, int seq, char* lds, int wv) {
    const int tid = otid(wv), wid = __builtin_amdgcn_readfirstlane(tid >> 6), lane = tid & 63, r32 = lane & 31, hi = lane >> 5;
    PG8_LAS char* l3 = (PG8_LAS char*)lds;
    char* V_lds = lds; char* K_lds = lds + OFF_K;
    float* wsl = (float*)(lds + OFF_W) + wid * 64; float* li_l = wsl; float* al_l = wsl + 32;
    float m_reg = -1e30f, l_reg = 0; f32x16 o[4] = {}; bf16x8 qr[NQREG];
    char* qrl = lds + QPARK_OFF + tid * 16;
    const bf16_t* Qw = Qb + (long)(wid * QBLK + r32) * LDQ + hi * 8;
#pragma unroll
    for (int d0 = 0; d0 < NQREG; ++d0) qr[d0] = *reinterpret_cast<const bf16x8*>(Qw + d0 * 16);
#pragma unroll
    for (int d0 = NQREG; d0 < 12; ++d0) *reinterpret_cast<bf16x8*>(qrl + (d0 - NQREG) * 8192) = *reinterpret_cast<const bf16x8*>(Qw + d0 * 16);
    int kg[3], vg[2];
#pragma unroll
    for (int i = 0; i < 3; ++i) { const int p = (wid * 3 + i) * 64 + lane, row = p / 24, cp = p % 24, c = cp ^ ((row >> 1) & 7); kg[i] = row * LDK + c * 8; }
#pragma unroll
    for (int i = 0; i < 2; ++i) { const int sl = (wid * 2 + i) * 64 + lane, kk = ((sl >> 7) << 3) | ((sl >> 2) & 7), c = ((sl >> 5) & 3) * 32 + (sl & 3) * 8;
        const int k = (kk & ~0xC) | ((kk & 4) << 1) | ((kk & 8) >> 1); vg[i] = k * LDV + c; }
    const int vb0 = (int)(uintptr_t)V_lds + v_rd_base(lane);
    const int klds_i = (int)(uintptr_t)K_lds;
    int ko[4];
#pragma unroll
    for (int e = 0; e < 4; ++e) ko[e] = r32 * 384 + (((e * 2 + hi) ^ ((r32 >> 1) & 7)) << 4);
#define KISSUE(tile, buf) do { const bf16_t* Kt_ = Kh + (size_t)(tile) * (KVBLK * LDK); _Pragma("unroll") for (int i_ = 0; i_ < 3; ++i_) \
    __builtin_amdgcn_global_load_lds((const unsigned*)(Kt_ + kg[i_]), (PG8_LAS unsigned*)(l3 + OFF_K + (buf) * SHM_K + (wid * 3 + i_) * 1024), 16, 0, 0); } while (0)
#define VISSUE(tile, buf) do { const bf16_t* Vt_ = Vh + (size_t)(tile) * (KVBLK * LDV); _Pragma("unroll") for (int i_ = 0; i_ < 2; ++i_) \
    __builtin_amdgcn_global_load_lds((const unsigned*)(Vt_ + vg[i_]), (PG8_LAS unsigned*)(l3 + (buf) * SHM_V + (wid * 2 + i_) * 1024), 16, 0, 0); } while (0)
#define WAITV(n) asm volatile("s_waitcnt vmcnt(" #n ")" ::: "memory")
#define WBAR() do { __builtin_amdgcn_s_barrier(); asm volatile("" ::: "memory"); } while (0)
#define NEXT3(x) ((x) == 2 ? 0 : (x) + 1)
#define RESC(a) do { if (__any((a) < 1.f)) { if (hi == 0) al_l[r32] = (a); asm volatile("s_waitcnt lgkmcnt(0)" ::: "memory"); \
    _Pragma("unroll") for (int d = 0; d < 4; ++d) _Pragma("unroll") for (int r = 0; r < 16; ++r) o[d][r] *= al_l[crow(r, hi)]; } } while (0)
    f32x16 pA0, pA1, pB0, pB1; float mnA, mnB, alA, alB; bf16x8 pa0, pa1, pa2, pa3; const int NT = seq / KVBLK;
    WAITV(0);
    KISSUE(0, 0);
    KISSUE(1, 1); VISSUE(0, 0);
    WAITV(5); WBAR();
    KISSUE(2, 2); VISSUE(1, 1);
    qkt(pA0, pA1, klds_i, qr, ko, qrl); partialSM(pA0, pA1, m_reg, mnA, alA);
    int kb = 1, vbi = 0;
    const int half = wid >> 2;
#define STEP_A(PC0, PC1, MNC, ALC, PP0, PP1, ALP) do { \
        SBAR(); qkt(PC0, PC1, klds_i + kb * SHM_K, qr, ko, qrl); \
        finishSM(PP0, PP1, ALP, l_reg, pa0, pa1, pa2, pa3); SBAR(); \
        pv_d0(o, vb0 + vbi * SHM_V, pa0, pa1, pa2, pa3); partialSM(PC0, PC1, m_reg, MNC, ALC); \
        RESC(ALC); kb = NEXT3(kb); vbi = NEXT3(vbi); } while (0)
#define STEP_B(PC0, PC1, MNC, ALC, PP0, PP1, ALP) do { \
        SBAR(); finishSM(PP0, PP1, ALP, l_reg, pa0, pa1, pa2, pa3); SBAR(); \
        qkt(PC0, PC1, klds_i + kb * SHM_K, qr, ko, qrl); SBAR(); \
        partialSM(PC0, PC1, m_reg, MNC, ALC); SBAR(); \
        pv_d0_1(o, vb0 + vbi * SHM_V, pa0, pa1, pa2, pa3); \
        RESC(ALC); kb = NEXT3(kb); vbi = NEXT3(vbi); } while (0)
#define MAINLOOP(STEP) for (int j = 1; j + 1 < NT; j += 2) { \
        WAITV(5); WBAR(); \
        { const int k2 = NEXT3(NEXT3(kb)), v1 = NEXT3(NEXT3(vbi)); KISSUE(j + 2, k2); VISSUE(j + 1, v1); } \
        STEP(pB0, pB1, mnB, alB, pA0, pA1, alA); \
        WAITV(5); WBAR(); \
        { const int k2 = NEXT3(NEXT3(kb)), v1 = NEXT3(NEXT3(vbi)); if (j + 3 < NT) KISSUE(j + 3, k2); VISSUE(j + 2, v1); } \
        STEP(pA0, pA1, mnA, alA, pB0, pB1, alB); }
    (void)half; MAINLOOP(STEP_A)
    WAITV(0); WBAR();
    SBAR(); qkt(pB0, pB1, klds_i + kb * SHM_K, qr, ko, qrl);
    finishSM(pA0, pA1, alA, l_reg, pa0, pa1, pa2, pa3); SBAR();
    pv_d0(o, vb0 + vbi * SHM_V, pa0, pa1, pa2, pa3); partialSM(pB0, pB1, m_reg, mnB, alB);
    RESC(alB);
    vbi = NEXT3(vbi);
    finishSM(pB0, pB1, alB, l_reg, pa0, pa1, pa2, pa3); SBAR();
    pv_d0(o, vb0 + vbi * SHM_V, pa0, pa1, pa2, pa3);
    if (hi == 0) li_l[r32] = l_reg; asm volatile("s_waitcnt lgkmcnt(0)" ::: "memory");
    int er = wid * QBLK + 4 * hi; asm volatile("" : "+v"(er));
#pragma unroll
    for (int r = 0; r < 16; ++r) { const int ro = er + (r & 3) + 8 * (r >> 2); const float rli = __builtin_amdgcn_rcpf(li_l[ro - wid * QBLK]);
        const bf16_t* zp = Zb + ro * LDP + r32; bf16_t* yp = Yb + ro * 2048 + r32; float sq = 0.f;
#pragma unroll
        for (int d0 = 0; d0 < 4; ++d0) { const float z = bf2f(zp[d0 * 32]); const float y = o[d0][r] * rli * silu(z); sq += y * y; yp[d0 * 32] = f2bf(y); }
        sq += __shfl_xor(sq, 1); sq += __shfl_xor(sq, 2); sq += __shfl_xor(sq, 4); sq += __shfl_xor(sq, 8); sq += __shfl_xor(sq, 16);
        if (r32 == 0) Sq[ro * 8] = sq; }
    __syncthreads();
#undef STEP_A
#undef STEP_B
#undef MAINLOOP
#undef KISSUE
#undef VISSUE
#undef WAITV
#undef WBAR
#undef NEXT3
#undef RESC
}
}

struct TrJob { const float* W; const float* gain; bf16_t* Wt; int K, N, Npad, krot; };
__device__ __forceinline__ void tr_load(const TrJob& J, int tile, int tid, f32x4 (&v)[8]) {
    const int ntn = J.Npad / 128, tk = tile / ntn, tn = tile % ntn, k0 = tk * 128, n0 = tn * 128, c4 = (tid & 31) * 4, r0 = tid >> 5;
#pragma unroll
    for (int i = 0; i < 8; ++i) { const int k = k0 + r0 + i * 16; f32x4 x = (f32x4){0.f, 0.f, 0.f, 0.f};
        if (n0 + c4 < J.N) { x = *(const f32x4*)(J.W + (size_t)k * J.N + n0 + c4); if (J.gain) { const float g = J.gain[k]; x = x * g; } }
        v[i] = x; }
}
constexpr int TR_IN = (2048 / 128) * (LDP / 128), TR_UKV = (512 / 128) * (2048 / 128), TR_SQ = (2048 / 128) * (2048 / 128), TR_PP = (256 / 128) * (2048 / 128);
constexpr int TR_E0 = DEPTH * TR_IN, TR_E1 = TR_E0 + DEPTH * TR_UKV, TR_E2 = TR_E1 + DEPTH * TR_SQ, TR_E3 = TR_E2 + DEPTH * TR_SQ, TR_E4 = TR_E3 + DEPTH * TR_PP;
__device__ __forceinline__ TrJob tr_decode(KPtr P, int g, int& tile) {
    unsigned char* ws = P->ws; TrJob J;
    if (g < TR_E0) { const int l = g / TR_IN; tile = g - l * TR_IN; J = TrJob{P->w_in + (size_t)l * 2048 * IN_W, P->attn_norm + l * 2048, (bf16_t*)(ws + WS_WT_IN) + (size_t)l * LDP * 2048, 2048, IN_W, LDP, 0}; }
    else if (g < TR_E1) { const int q = g - TR_E0, l = q / TR_UKV; tile = q - l * TR_UKV; J = TrJob{P->w_ukv + (size_t)l * 512 * 2048, P->kv_norm + l * 512, (bf16_t*)(ws + WS_WT_UKV) + (size_t)l * 2048 * 512, 512, 2048, 2048, 0}; }
    else if (g < TR_E2) { const int q = g - TR_E1, l = q / TR_SQ; tile = q - l * TR_SQ; J = TrJob{P->w_out + (size_t)l * 2048 * 2048, P->out_norm + l * 2048, (bf16_t*)(ws + WS_WT_OUT) + (size_t)l * 2048 * 2048, 2048, 2048, 2048, 1024}; }
    else if (g < TR_E3) { const int q = g - TR_E2, l = q / TR_SQ; tile = q - l * TR_SQ; J = TrJob{P->w_ple_gate + (size_t)l * 2048 * 2048, P->ple_norm + l * 2048, (bf16_t*)(ws + WS_WT_G) + (size_t)l * 2048 * 2048, 2048, 2048, 2048, 0}; }
    else { const int q = g - TR_E3, l = q / TR_PP; tile = q - l * TR_PP; J = TrJob{P->w_ple_proj + (size_t)l * 256 * 2048, nullptr, (bf16_t*)(ws + WS_WT_PP) + (size_t)l * 2048 * 256, 256, 2048, 2048, 0}; }
    return J;
}
__device__ __forceinline__ void transpose_flat(KPtr P, float* lds, int wv) {
    const int tid = otid(wv);
    int g = blockIdx.x; if (g >= TR_E4) return;
    int tile; TrJob J = tr_decode(P, g, tile);
    f32x4 v[8]; tr_load(J, tile, tid, v);
    for (;;) {
        const int c4 = (tid & 31) * 4, r0 = tid >> 5;
#pragma unroll
        for (int i = 0; i < 8; ++i) { float* d = lds + (r0 + i * 16) * 129 + c4; d[0] = v[i][0]; d[1] = v[i][1]; d[2] = v[i][2]; d[3] = v[i][3]; }
        __syncthreads();
        const TrJob Jc = J; const int cur = tile; g += gridDim.x; const bool more = g < TR_E4;
        if (more) { J = tr_decode(P, g, tile); tr_load(J, tile, tid, v); }
        const int ntn = Jc.Npad / 128, tk = cur / ntn, tn = cur % ntn, k0 = tk * 128, n0 = tn * 128;
#pragma unroll
        for (int j = 0; j < 4; ++j) { const int c = tid + j * 512, kc = c & 15, n = c >> 4; const float* sp = lds + (kc * 8) * 129 + n;
            u32x4 w; w.x = cvt_pk_bf16(sp[0], sp[129]); w.y = cvt_pk_bf16(sp[2 * 129], sp[3 * 129]); w.z = cvt_pk_bf16(sp[4 * 129], sp[5 * 129]); w.w = cvt_pk_bf16(sp[6 * 129], sp[7 * 129]);
            *(u32x4*)(Jc.Wt + (size_t)(n0 + n) * Jc.K + ((k0 + Jc.krot) % Jc.K) + kc * 8) = w; }
        __syncthreads();
        if (!more) break;
    }
}
__device__ void phase_prep(KPtr P, float* lds, int wv) {
    unsigned char* ws = P->ws;
    transpose_flat(P, lds, wv);
    { const size_t n4 = (size_t)DEPTH * T * PLE / 4; const f32x4* src = (const f32x4*)P->p; u32x2* dst = (u32x2*)(ws + WS_PB);
      for (size_t i = (size_t)blockIdx.x * NTHR + otid(wv); i < n4; i += (size_t)gridDim.x * NTHR) { const f32x4 v = src[i]; u32x2 w; w.x = cvt_pk_bf16(v[0], v[1]); w.y = cvt_pk_bf16(v[2], v[3]); dst[i] = w; } }
    { float* cs = (float*)(ws + WS_COS); float* sn = (float*)(ws + WS_SIN);
      for (int i = blockIdx.x * NTHR + otid(wv); i < T * 32; i += gridDim.x * NTHR) { const int t = i >> 5, f = i & 31;
          const double inv = exp(-(double)(2 * f) / 64.0 * 9.210340371976184); const double ang = (double)P->positions[t] * inv; cs[i] = (float)cos(ang); sn[i] = (float)sin(ang); } }
}
__device__ void phase_rownorm_bf(const bf16_t* __restrict__ src, bf16_t* __restrict__ dst, int wv) {
    const int tid = otid(wv), wid = tid >> 6, lane = tid & 63, stride = gridDim.x * 8;
    for (int row = blockIdx.x * 8 + wid; row < T; row += stride) {
        const u32x4* p = (const u32x4*)(src + (size_t)row * 2048); float f[4][8]; float ss = 0.f;
#pragma unroll
        for (int j = 0; j < 4; ++j) { unpack8(p[lane + 64 * j], f[j]);
#pragma unroll
            for (int e = 0; e < 8; ++e) ss += f[j][e] * f[j][e]; }
        ss = wave_sum(ss); const float rs = rsqrtf(ss * (1.f / 2048.f) + EPS);
        u32x4* d = (u32x4*)(dst + (size_t)row * 2048);
#pragma unroll
        for (int j = 0; j < 4; ++j) {
#pragma unroll
            for (int e = 0; e < 8; ++e) f[j][e] *= rs;
            d[lane + 64 * j] = pack8(f[j]); }
    }
}
__device__ void phase_rownorm(const float* __restrict__ src, bf16_t* __restrict__ dst, int wv) {
    const int tid = otid(wv), wid = tid >> 6, lane = tid & 63, stride = gridDim.x * 8;
    int row = blockIdx.x * 8 + wid; f32x4 v[8], nv[8];
    if (row < T) { const f32x4* p = (const f32x4*)(src + (size_t)row * 2048);
#pragma unroll
        for (int j = 0; j < 8; ++j) v[j] = p[lane + 64 * j]; }
    for (; row < T; row += stride) {
        const int rn = row + stride; const bool more = rn < T;
        if (more) { const f32x4* p = (const f32x4*)(src + (size_t)rn * 2048);
#pragma unroll
            for (int j = 0; j < 8; ++j) nv[j] = p[lane + 64 * j]; }
        float ss = 0.f;
#pragma unroll
        for (int j = 0; j < 8; ++j) ss += v[j][0] * v[j][0] + v[j][1] * v[j][1] + v[j][2] * v[j][2] + v[j][3] * v[j][3];
        ss = wave_sum(ss); const float rs = rsqrtf(ss * (1.f / 2048.f) + EPS);
        u32x2* d = (u32x2*)(dst + (size_t)row * 2048);
#pragma unroll
        for (int j = 0; j < 8; ++j) { u32x2 w; w.x = cvt_pk_bf16(v[j][0] * rs, v[j][1] * rs); w.y = cvt_pk_bf16(v[j][2] * rs, v[j][3] * rs); d[lane + 64 * j] = w; }
        if (more) {
#pragma unroll
            for (int j = 0; j < 8; ++j) v[j] = nv[j]; }
    }
}
__device__ void phase_post_rows(KPtr P, int l, int wv) {
    unsigned char* ws = P->ws; const bf16_t* __restrict__ PROJ = (const bf16_t*)(ws + WS_PROJ); bf16_t* __restrict__ Q = (bf16_t*)(ws + WS_Q); bf16_t* __restrict__ Kb = (bf16_t*)(ws + WS_K);
    bf16_t* __restrict__ CK = (bf16_t*)(ws + WS_CKVN); bf16_t* __restrict__ Y = (bf16_t*)(ws + WS_Y); const float* __restrict__ COS = (const float*)(ws + WS_COS); const float* __restrict__ SIN = (const float*)(ws + WS_SIN);
    const int tid = otid(wv), wid = tid >> 6, lane = tid & 63, h = lane >> 3, sub = lane & 7, ch = lane * 8, fi = (sub & 3) * 8;
    float gqn[16], gqr[8], gkr[8], w0[8], w1[8], w2[8], cb[8];
    { const float* qn_g = P->q_nope_norm + l * 128 + sub * 16; const float* qr_g = P->q_rope_norm + l * 64 + sub * 8; const float* kr_g = P->k_rope_norm + l * 64 + sub * 8;
      const float* cw = P->conv_w + (size_t)l * 3 * 512 + ch; const float* cbias = P->conv_b + (size_t)l * 512 + ch;
#pragma unroll
      for (int e = 0; e < 16; ++e) gqn[e] = qn_g[e];
#pragma unroll
      for (int e = 0; e < 8; ++e) { gqr[e] = qr_g[e]; gkr[e] = kr_g[e]; w0[e] = cw[e]; w1[e] = cw[512 + e]; w2[e] = cw[1024 + e]; cb[e] = cbias[e]; } }
    for (int t = blockIdx.x * 8 + wid; t < T; t += gridDim.x * 8) {
        const int b = t / SEQ, s = t % SEQ; const bf16_t* pr = PROJ + (size_t)t * LDP;
        const size_t qo = ((size_t)(b * 8 + h) * SEQ + s) * 192;
        const bool hasm = s > 0, hasp = s < SEQ - 1; const u32x4 zero4 = {0u, 0u, 0u, 0u};
        const u32x4 lqn0 = *(const u32x4*)(pr + OFF_CQ + 192 * h + sub * 16), lqn1 = *(const u32x4*)(pr + OFF_CQ + 192 * h + sub * 16 + 8);
        const u32x4 lqr = *(const u32x4*)(pr + OFF_CQ + 192 * h + 128 + sub * 8), lkr = *(const u32x4*)(pr + OFF_CKR + sub * 8), lkv = *(const u32x4*)(pr + OFF_CKV + ch);
        const u32x4 lbb = *(const u32x4*)(pr + OFF_BB + ch), lc0 = *(const u32x4*)(pr + OFF_BC + ch), lh0 = *(const u32x4*)(pr + OFF_BH + ch), lzz = *(const u32x4*)(pr + OFF_BZ + ch);
        const u32x4 lcm = hasm ? *(const u32x4*)(pr - LDP + OFF_BC + ch) : zero4, lhm = hasm ? *(const u32x4*)(pr - LDP + OFF_BH + ch) : zero4;
        const u32x4 lcp = hasp ? *(const u32x4*)(pr + LDP + OFF_BC + ch) : zero4, lhp = hasp ? *(const u32x4*)(pr + LDP + OFF_BH + ch) : zero4;
        const f32x4 lc0s = *(const f32x4*)(COS + (size_t)t * 32 + fi), lc1s = *(const f32x4*)(COS + (size_t)t * 32 + fi + 4), ls0s = *(const f32x4*)(SIN + (size_t)t * 32 + fi), ls1s = *(const f32x4*)(SIN + (size_t)t * 32 + fi + 4);
        float cs[8], sn[8];
#pragma unroll
        for (int e = 0; e < 4; ++e) { cs[e] = lc0s[e]; cs[4 + e] = lc1s[e]; sn[e] = ls0s[e]; sn[4 + e] = ls1s[e]; }
        {
            float f[16]; unpack8(lqn0, f); unpack8(lqn1, f + 8);
            float ss = 0.f;
#pragma unroll
            for (int e = 0; e < 16; ++e) ss += f[e] * f[e];
            ss = sum8(ss); const float rs = rsqrtf(ss * (1.f / 128.f) + EPS);
#pragma unroll
            for (int e = 0; e < 16; ++e) f[e] = f[e] * rs * gqn[e];
            u32x4* d = (u32x4*)(Q + qo + sub * 16); d[0] = pack8(f); d[1] = pack8(f + 8);
        }
        {
            float f[8]; unpack8(lqr, f);
            float ss = 0.f;
#pragma unroll
            for (int e = 0; e < 8; ++e) ss += f[e] * f[e];
            ss = sum8(ss); const float rs = rsqrtf(ss * (1.f / 64.f) + EPS); float o8[8];
#pragma unroll
            for (int e = 0; e < 8; ++e) { const float xn = f[e] * rs * gqr[e]; const float pt = __shfl_xor(xn, 4);
                o8[e] = (sub < 4) ? (xn * cs[e] - pt * sn[e]) : (xn * cs[e] + pt * sn[e]); }
            *(u32x4*)(Q + qo + 128 + sub * 8) = pack8(o8);
        }
        {
            float f[8]; unpack8(lkr, f);
            float ss = 0.f;
#pragma unroll
            for (int e = 0; e < 8; ++e) ss += f[e] * f[e];
            ss = sum8(ss); const float rs = rsqrtf(ss * (1.f / 64.f) + EPS); float o8[8];
#pragma unroll
            for (int e = 0; e < 8; ++e) { const float xn = f[e] * rs * gkr[e]; const float pt = __shfl_xor(xn, 4);
                o8[e] = (sub < 4) ? (xn * cs[e] - pt * sn[e]) : (xn * cs[e] + pt * sn[e]); }
            *(u32x4*)(Kb + qo + 128 + sub * 8) = pack8(o8);
        }
        {
            float f[8]; unpack8(lkv, f);
            float ss = 0.f;
#pragma unroll
            for (int e = 0; e < 8; ++e) ss += f[e] * f[e];
            ss = wave_sum(ss); const float rs = rsqrtf(ss * (1.f / 512.f) + EPS);
#pragma unroll
            for (int e = 0; e < 8; ++e) f[e] *= rs;
            *(u32x4*)(CK + (size_t)t * 512 + ch) = pack8(f);
        }
        {
            float bb[8], c0[8], h0[8], zz[8], cm[8], hm[8], cp[8], hp[8];
            unpack8(lbb, bb); unpack8(lc0, c0); unpack8(lh0, h0); unpack8(lzz, zz); unpack8(lcm, cm); unpack8(lhm, hm); unpack8(lcp, cp); unpack8(lhp, hp);
            float o8[8]; float ssb = 0.f;
#pragma unroll
            for (int e = 0; e < 8; ++e) { const float y = cb[e] + w0[e] * (cm[e] * hm[e]) + w1[e] * (c0[e] * h0[e]) + w2[e] * (cp[e] * hp[e]);
                o8[e] = bb[e] * y * silu(zz[e]); ssb += o8[e] * o8[e]; }
            ssb = wave_sum(ssb); const float rsb = rsqrtf(ssb * (1.f / 512.f) + EPS);
#pragma unroll
            for (int e = 0; e < 8; ++e) o8[e] *= rsb;
            *(u32x4*)(Y + (size_t)t * 2048 + YB + ch) = pack8(o8);
        }
    }
}
__device__ void phase_sgu(KPtr P, int l, char* lds, int wv) {
    unsigned char* ws = P->ws; const bf16_t* __restrict__ PROJ = (const bf16_t*)(ws + WS_PROJ); bf16_t* __restrict__ Y = (bf16_t*)(ws + WS_Y);
    const int tid = otid(wv), wid = tid >> 6, lane = tid & 63, fr = lane & 15, fq = lane >> 4;
    constexpr int VST = 264;
    for (int unit = blockIdx.x; unit < (T / 128) * 4; unit += gridDim.x) {
        const int k = unit >> 2, h = unit & 3, t0 = k * 128, n0 = wid * 16, t = t0 + n0 + fr;
        bf16_t r0[16], r1[16];
#pragma unroll
        for (int i = 0; i < 16; ++i) { const bf16_t* pv = PROJ + (size_t)(t0 + wid * 16 + i) * LDP + OFF_AV + h * 128; r0[i] = pv[lane]; r1[i] = pv[lane + 64]; }
        const float* sg = P->sgu_norm + (size_t)(l * 4 + h) * 128; const float g0 = sg[lane], g1 = sg[lane + 64];
        const float* wsp = P->w_spatial + ((size_t)(l * 4 + h) * 128 + n0 + fr) * 128 + fq * 8;
        f32x4 wa[4], wc[4];
#pragma unroll
        for (int kk = 0; kk < 4; ++kk) { wa[kk] = *(const f32x4*)(wsp + kk * 32); wc[kk] = *(const f32x4*)(wsp + kk * 32 + 4); }
        const float bias = P->b_spatial[(size_t)(l * 4 + h) * 128 + n0 + fr]; const bf16_t* pr = PROJ + (size_t)t * LDP + h * 128 + fq * 4;
        u32x2 uw[8], zw[8];
#pragma unroll
        for (int ct = 0; ct < 8; ++ct) { uw[ct] = *(const u32x2*)(pr + OFF_AU + ct * 16); zw[ct] = *(const u32x2*)(pr + OFF_AZ + ct * 16); }
#pragma unroll
        for (int i = 0; i < 16; ++i) { const int m = wid * 16 + i;
            const float x0 = bf2f(r0[i]), x1 = bf2f(r1[i]); const float ss = wave_sum(x0 * x0 + x1 * x1); const float rs = rsqrtf(ss * (1.f / 128.f) + EPS);
            *(bf16_t*)(lds + lane * VST + m * 2) = f2bf(x0 * rs * g0); *(bf16_t*)(lds + (lane + 64) * VST + m * 2) = f2bf(x1 * rs * g1); }
        __syncthreads();
        bf16x8 bw[4];
#pragma unroll
        for (int kk = 0; kk < 4; ++kk) { const f32x4 a = wa[kk], c = wc[kk];
            u32x4 w; w.x = cvt_pk_bf16(a[0], a[1]); w.y = cvt_pk_bf16(a[2], a[3]); w.z = cvt_pk_bf16(c[0], c[1]); w.w = cvt_pk_bf16(c[2], c[3]); bw[kk] = *reinterpret_cast<bf16x8*>(&w); }
        f32x4 acc[8];
#pragma unroll
        for (int ct = 0; ct < 8; ++ct) { acc[ct] = (f32x4){0.f, 0.f, 0.f, 0.f};
#pragma unroll
            for (int kk = 0; kk < 4; ++kk) { const char* ap = lds + (ct * 16 + fr) * VST + (kk * 32 + fq * 8) * 2;
                const u32x2 lo = *(const u32x2*)ap, hi2 = *(const u32x2*)(ap + 8); u32x4 w = {lo.x, lo.y, hi2.x, hi2.y};
                acc[ct] = __builtin_amdgcn_mfma_f32_16x16x32_bf16(*reinterpret_cast<bf16x8*>(&w), bw[kk], acc[ct], 0, 0, 0); } }
        float ssa = 0.f;
#pragma unroll
        for (int ct = 0; ct < 8; ++ct) {
            const float v0 = bflo(uw[ct].x) * (acc[ct][0] + bias) * silu(bflo(zw[ct].x)), v1 = bfhi(uw[ct].x) * (acc[ct][1] + bias) * silu(bfhi(zw[ct].x));
            const float v2 = bflo(uw[ct].y) * (acc[ct][2] + bias) * silu(bflo(zw[ct].y)), v3 = bfhi(uw[ct].y) * (acc[ct][3] + bias) * silu(bfhi(zw[ct].y));
            ssa += (v0 * v0 + v1 * v1) + (v2 * v2 + v3 * v3);
            u32x2 w; w.x = cvt_pk_bf16(v0, v1); w.y = cvt_pk_bf16(v2, v3); *(u32x2*)(Y + (size_t)t * 2048 + YA + h * 128 + ct * 16 + fq * 4) = w; }
        ssa += __shfl_xor(ssa, 16); ssa += __shfl_xor(ssa, 32);
        if (fq == 0) ((float*)(ws + WS_SSQA))[(size_t)t * 4 + h] = ssa;
        __syncthreads();
    }
}
__device__ void phase_attn(KPtr P, char* lds, int wv) {
    unsigned char* ws = P->ws; const bf16_t* Q = (const bf16_t*)(ws + WS_Q); const bf16_t* Kb = (const bf16_t*)(ws + WS_K); const bf16_t* KV = (const bf16_t*)(ws + WS_KV);
    const bf16_t* PROJ = (const bf16_t*)(ws + WS_PROJ); bf16_t* Y = (bf16_t*)(ws + WS_Y);
    for (int v = blockIdx.x; v < BATCH * 8 * (SEQ / 256); v += gridDim.x) {
        const int h = v & 7, qb = (v >> 3) & 31, b = v >> 8; const size_t tq = (size_t)b * SEQ + qb * 256;
        att::attn_body(Q + ((size_t)(b * 8 + h) * SEQ + qb * 256) * 192, Kb + (size_t)(b * 8 + h) * SEQ * 192, KV + (size_t)b * SEQ * 2048 + h * 256 + 128,
                       PROJ + tq * LDP + OFF_CZ + h * 128, Y + tq * 2048 + YC + h * 128, (float*)(ws + WS_SSQC) + tq * 8 + h, SEQ, lds, wv);
    }
}

constexpr int LDS_BYTES = pg8::STAGE_BYTES + 16 + 4096 + att::SHM_QPARK;
static_assert(att::QPARK_OFF == pg8::STAGE_BYTES + 16 + 4096 && LDS_BYTES <= 160 * 1024, "LDS map");
static_assert(att::SHM_ATTN <= pg8::STAGE_BYTES, "attention LDS");
__global__ void __launch_bounds__(NTHR, 2) fwd_megakernel(Params P_args) {
    extern __shared__ __attribute__((aligned(16))) unsigned char lds[];
    cg::grid_group grid = cg::this_grid();
    unsigned char* ws = kp_fresh()->ws; const int G = gridDim.x;
    bf16_t* HN = (bf16_t*)(ws + WS_Y); bf16_t* Y = (bf16_t*)(ws + WS_Y); bf16_t* PROJ = (bf16_t*)(ws + WS_PROJ); bf16_t* PPb = (bf16_t*)(ws + WS_PP);
    bf16_t* CK = (bf16_t*)(ws + WS_CKVN); bf16_t* KV = (bf16_t*)(ws + WS_KV); bf16_t* Kb = (bf16_t*)(ws + WS_K);
    PG8_LAS unsigned char* llds = (PG8_LAS unsigned char*)lds;
    volatile PG8_LAS unsigned* bst = (volatile PG8_LAS unsigned*)(llds + pg8::STAGE_BYTES);
    const int wv = __builtin_amdgcn_readfirstlane((int)threadIdx.x >> 6);
    { const int t0_ = otid(wv); if (t0_ < 4) bst[t0_] = 0u; }
    __syncthreads();
    XcdBarrier xb = xcd_barrier_post((unsigned*)(ws + WS_BAR), bst, wv);
#define GSYNC() xcd_barrier(xb, wv)

    phase_prep(kp_fresh(), (float*)lds, wv);
    grid.sync();
    for (int l = 0; l < DEPTH; ++l) {
        bf16_t* H2 = (bf16_t*)(ws + WS_H2);
        if (l == 0) phase_rownorm(kp_fresh()->x, HN, wv); else phase_rownorm_bf(H2, HN, wv);
        GSYNC();
        { pg8::Gemm g{HN, (const bf16_t*)(ws + WS_WT_IN) + (size_t)l * LDP * 2048, T, LDP, 2048}; pg8::StaticOrder S; S.init(T, LDP, G, (int)blockIdx.x);
          pg8::EpiBf16Store E{PROJ, LDP}; pg8::gemm_phase(llds, g, S, E, wv); }
        GSYNC();
        phase_sgu(kp_fresh(), l, (char*)lds, wv);
        phase_post_rows(kp_fresh(), l, wv);
        GSYNC();
        { pg8::Gemm g{CK, (const bf16_t*)(ws + WS_WT_UKV) + (size_t)l * 2048 * 512, T, 2048, 512}; pg8::StaticOrder S; S.init(T, 2048, G, (int)blockIdx.x);
          pg8::EpiKV E{Kb, KV, kp_fresh()->k_nope_norm + l * 128, (PG8_LAS float*)(llds + pg8::STAGE_BYTES + 16)}; pg8::gemm_phase(llds, g, S, E, wv); }
        { pg8::Gemm g{(const bf16_t*)(ws + WS_PB) + (size_t)l * T * 256, (const bf16_t*)(ws + WS_WT_PP) + (size_t)l * 2048 * 256, T, 2048, 256}; pg8::StaticOrder S; S.init(T, 2048, G, (int)blockIdx.x);
          pg8::EpiBf16Store E{PPb, 2048}; pg8::gemm_phase(llds, g, S, E, wv); }
        GSYNC();
        phase_attn(kp_fresh(), (char*)lds, wv);
        GSYNC();
        { pg8::Gemm g{Y, (const bf16_t*)(ws + WS_WT_OUT) + (size_t)l * 2048 * 2048, T, 2048, 2048}; pg8::StaticOrder S; S.init(T, 2048, G, (int)blockIdx.x);
          if (l == 0) { pg8::EpiResMid<false> E{kp_fresh()->x, (const float*)(ws + WS_SSQA), (const float*)(ws + WS_SSQC), (bf16_t*)(ws + WS_KV), (float*)(ws + WS_SSQ2)}; pg8::gemm_phase(llds, g, S, E, wv); }
          else { pg8::EpiResMid<true> E{H2, (const float*)(ws + WS_SSQA), (const float*)(ws + WS_SSQC), (bf16_t*)(ws + WS_KV), (float*)(ws + WS_SSQ2)}; pg8::gemm_phase(llds, g, S, E, wv); } }
        GSYNC();
        { pg8::Gemm g{(const bf16_t*)(ws + WS_KV), (const bf16_t*)(ws + WS_WT_G) + (size_t)l * 2048 * 2048, T, 2048, 2048}; pg8::StaticOrder S; S.init(T, 2048, G, (int)blockIdx.x);
          if (l + 1 < DEPTH) { pg8::EpiGate<false> E{(const bf16_t*)(ws + WS_KV), PPb, (const float*)(ws + WS_SSQ2), H2}; pg8::gemm_phase(llds, g, S, E, wv); }
          else { pg8::EpiGate<true> E{(const bf16_t*)(ws + WS_KV), PPb, (const float*)(ws + WS_SSQ2), kp_fresh()->out}; pg8::gemm_phase(llds, g, S, E, wv); } }
        if (l + 1 < DEPTH) GSYNC();
    }
}

extern "C" void kernel_launch(void* const* d_in, const int* in_sizes, int n_in, void* d_out, int out_size, void* d_ws, size_t ws_size, hipStream_t stream) {
    static int grid_blocks = 0;
    if (grid_blocks == 0) {
        if (n_in != 21 || out_size != T * D_MODEL || ws_size < WS_END) { fprintf(stderr, "kernel_launch: unexpected shapes (n_in %d, out %d, ws %zu need %zu)\n", n_in, out_size, ws_size, (size_t)WS_END); grid_blocks = -1; return; }
        int dev = 0, cus = 0, per_cu = 0;
        hipGetDevice(&dev); hipDeviceGetAttribute(&cus, hipDeviceAttributeMultiprocessorCount, dev);
        if (hipFuncSetAttribute((const void*)fwd_megakernel, hipFuncAttributeMaxDynamicSharedMemorySize, LDS_BYTES) != hipSuccess) { fprintf(stderr, "kernel_launch: hipFuncSetAttribute failed\n"); grid_blocks = -1; return; }
        hipOccupancyMaxActiveBlocksPerMultiprocessor(&per_cu, (const void*)fwd_megakernel, NTHR, LDS_BYTES);
        if (per_cu < 1) { fprintf(stderr, "kernel_launch: occupancy query says %d blocks per CU\n", per_cu); per_cu = 1; }
        if (per_cu > 1) per_cu = 1;
        grid_blocks = cus * per_cu;
    }
    if (grid_blocks < 0) return;
    Params P{};
    P.x = (const float*)d_in[0]; P.p = (const float*)d_in[1]; P.positions = (const int*)d_in[2]; P.attn_norm = (const float*)d_in[3]; P.w_in = (const float*)d_in[4];
    P.sgu_norm = (const float*)d_in[5]; P.w_spatial = (const float*)d_in[6]; P.b_spatial = (const float*)d_in[7]; P.conv_w = (const float*)d_in[8]; P.conv_b = (const float*)d_in[9];
    P.kv_norm = (const float*)d_in[10]; P.w_ukv = (const float*)d_in[11]; P.q_nope_norm = (const float*)d_in[12]; P.q_rope_norm = (const float*)d_in[13];
    P.k_nope_norm = (const float*)d_in[14]; P.k_rope_norm = (const float*)d_in[15]; P.out_norm = (const float*)d_in[16]; P.w_out = (const float*)d_in[17];
    P.ple_norm = (const float*)d_in[18]; P.w_ple_gate = (const float*)d_in[19]; P.w_ple_proj = (const float*)d_in[20]; P.out = (float*)d_out; P.ws = (unsigned char*)d_ws;
    if (hipMemsetAsync((unsigned char*)d_ws + WS_BAR, 0, 16384, stream) != hipSuccess) { fprintf(stderr, "kernel_launch: memset failed\n"); return; }
    void* args[] = {&P};
    hipError_t e = hipLaunchCooperativeKernel((const void*)fwd_megakernel, dim3(grid_blocks), dim3(NTHR), args, LDS_BYTES, stream);
    if (e != hipSuccess) fprintf(stderr, "kernel_launch: cooperative launch failed: %s (grid %d)\n", hipGetErrorString(e), grid_blocks);
}
```

```cpp
#include <hip/hip_runtime.h>
#include <hip/hip_cooperative_groups.h>
#include <cstdio>
#include <cstdint>
namespace cg = cooperative_groups;

constexpr int D_MODEL = 2048, BATCH = 2, SEQ = 8192, DEPTH = 4, T = BATCH * SEQ;
constexpr int PLE = 256, IN_W = 6720, LDP = 6912  ;
constexpr int OFF_AU = 0, OFF_AV = 512, OFF_AZ = 1024, OFF_BB = 1536, OFF_BC = 2048, OFF_BH = 2560, OFF_BZ = 3072,
              OFF_CQ = 3584, OFF_CKV = 5120, OFF_CKR = 5632, OFF_CZ = 5696;
constexpr float EPS = 1e-6f;
constexpr int NTHR = 512;
constexpr int YC = 0, YA = 1024, YB = 1536;

typedef unsigned short bf16_t;
typedef short bf16x8 __attribute__((ext_vector_type(8)));
typedef short s16x4 __attribute__((ext_vector_type(4)));
typedef float f32x4 __attribute__((ext_vector_type(4)));
typedef float f32x16 __attribute__((ext_vector_type(16)));
typedef unsigned u32x4 __attribute__((ext_vector_type(4)));
typedef unsigned u32x2 __attribute__((ext_vector_type(2)));

constexpr size_t SZ_WT_IN = (size_t)DEPTH * LDP * 2048 * 2, SZ_WT_UKV = (size_t)DEPTH * 2048 * 512 * 2, SZ_WT_SQ = (size_t)DEPTH * 2048 * 2048 * 2,
                 SZ_WT_PP = (size_t)DEPTH * 2048 * 256 * 2, SZ_PB = (size_t)DEPTH * T * 256 * 2, SZ_ACT = (size_t)T * 2048 * 2,
                 SZ_PROJ = (size_t)T * LDP * 2, SZ_CKVN = (size_t)T * 512 * 2, SZ_QK = (size_t)BATCH * 8 * SEQ * 192 * 2, SZ_ROPE = (size_t)T * 32 * 4;
constexpr size_t WS_WT_IN = 0, WS_WT_UKV = WS_WT_IN + SZ_WT_IN, WS_WT_OUT = WS_WT_UKV + SZ_WT_UKV, WS_WT_G = WS_WT_OUT + SZ_WT_SQ,
                 WS_WT_PP = WS_WT_G + SZ_WT_SQ, WS_PB = WS_WT_PP + SZ_WT_PP, WS_Y = WS_PB + SZ_PB  , WS_PROJ = WS_Y + SZ_ACT,
                 WS_PP = WS_PROJ + SZ_PROJ, WS_CKVN = WS_PP + SZ_ACT, WS_KV = WS_CKVN + SZ_CKVN, WS_Q = WS_KV + SZ_ACT, WS_K = WS_Q + SZ_QK,
                 WS_COS = WS_K + SZ_QK, WS_SIN = WS_COS + SZ_ROPE, WS_BAR = WS_SIN + SZ_ROPE, WS_SSQA = WS_BAR + 16384, WS_SSQC = WS_SSQA + (size_t)T * 4 * 4, WS_SSQ2 = WS_SSQC + (size_t)T * 8 * 4, WS_H2 = WS_SSQ2 + (size_t)T * 32 * 4, WS_END = WS_H2 + SZ_ACT;

struct Params {
    const float* x; const float* p; const int* positions; const float* attn_norm; const float* w_in; const float* sgu_norm; const float* w_spatial;
    const float* b_spatial; const float* conv_w; const float* conv_b; const float* kv_norm; const float* w_ukv; const float* q_nope_norm;
    const float* q_rope_norm; const float* k_nope_norm; const float* k_rope_norm; const float* out_norm; const float* w_out; const float* ple_norm;
    const float* w_ple_gate; const float* w_ple_proj; float* out; unsigned char* ws;
};

typedef const __attribute__((address_space(4))) Params* KPtr;
__device__ __forceinline__ KPtr kp_fresh() { KPtr k = (KPtr)__builtin_amdgcn_kernarg_segment_ptr(); asm volatile("" : "+s"(k)); return k; }
__device__ __forceinline__ int otid(int wv) { unsigned z = 0u; asm volatile("" : "+v"(z)); return (int)__builtin_amdgcn_mbcnt_hi(~0u, __builtin_amdgcn_mbcnt_lo(~0u, z)) + 64 * wv; }
__device__ __forceinline__ float bf2f(bf16_t u) { return __uint_as_float(((unsigned)u) << 16); }
__device__ __forceinline__ float bflo(unsigned w) { return __uint_as_float(w << 16); }
__device__ __forceinline__ float bfhi(unsigned w) { return __uint_as_float(w & 0xffff0000u); }
__device__ __forceinline__ unsigned cvt_pk_bf16(float lo, float hi) { unsigned r; asm volatile("v_cvt_pk_bf16_f32 %0, %1, %2" : "=v"(r) : "v"(lo), "v"(hi)); return r; }
__device__ __forceinline__ bf16_t f2bf(float f) { return (bf16_t)(cvt_pk_bf16(f, 0.f) & 0xffffu); }
__device__ __forceinline__ float wave_sum(float v) { v += __shfl_xor(v, 32); v += __shfl_xor(v, 16); v += __shfl_xor(v, 8); v += __shfl_xor(v, 4); v += __shfl_xor(v, 2); v += __shfl_xor(v, 1); return v; }
__device__ __forceinline__ float sum8(float v) { v += __shfl_xor(v, 4); v += __shfl_xor(v, 2); v += __shfl_xor(v, 1); return v; }
__device__ __forceinline__ float silu(float z) { return z / (1.f + __expf(-z)); }
__device__ __forceinline__ float sigmoidf(float z) { return 1.f / (1.f + __expf(-z)); }
__device__ __forceinline__ void unpack8(u32x4 w, float* f) { f[0] = bflo(w.x); f[1] = bfhi(w.x); f[2] = bflo(w.y); f[3] = bfhi(w.y); f[4] = bflo(w.z); f[5] = bfhi(w.z); f[6] = bflo(w.w); f[7] = bfhi(w.w); }
__device__ __forceinline__ u32x4 pack8(const float* f) { u32x4 w; w.x = cvt_pk_bf16(f[0], f[1]); w.y = cvt_pk_bf16(f[2], f[3]); w.z = cvt_pk_bf16(f[4], f[5]); w.w = cvt_pk_bf16(f[6], f[7]); return w; }

namespace pg8 {
#define PG8_LAS __attribute__((address_space(3)))
constexpr int BM = 256, BK = 64, HALF = 128, HTB = HALF * BK * 2, STAGE_BYTES = 8 * HTB, NXCD = 8, WGM = 8;
__host__ __device__ __forceinline__ int lds_byte(int r, int c) { const int st = (r >> 4) * 2 + (c >> 5), rr = r & 15, cc = c & 31, ob = rr * 64 + cc * 2; return st * 1024 + (ob ^ (((ob >> 9) & 1) << 5)); }
__host__ __device__ __forceinline__ void stage_rc(int b, int& R, int& C) { const int st = b / 1024, sb = b % 1024, swz = sb ^ (((sb >> 9) & 1) << 5); R = (st >> 1) * 16 + swz / 64; C = (st & 1) * 32 + (swz % 64) / 2; }
__host__ __device__ __forceinline__ int perm32(int rho) { const int n = rho >> 4, i = rho & 15; return 8 * (i >> 2) + 4 * n + (i & 3); }
struct Unit { int pm, pn; };
struct Gemm { const bf16_t* A; const bf16_t* Bt; int M, N, K; };
struct StaticOrder {
    int nM, nN, nwg, G, c;
    __device__ void init(int M, int N, int G_, int c_) { nM = M / BM; nN = N / BM; nwg = nM * nN; G = G_; c = c_; }
    __device__ bool next(int i, Unit& u) const {
        const long L = (long)i * G + c; if (L >= nwg) return false;
        int wgid = (int)L; { const int q = nwg / NXCD, r = nwg % NXCD, xcd = wgid % NXCD, off = wgid / NXCD; wgid = (xcd < r ? xcd * (q + 1) : r * (q + 1) + (xcd - r) * q) + off; }
        const int nig = WGM * nN, gid = wgid / nig, fm = gid * WGM, gsz = (nM - fm) < WGM ? (nM - fm) : WGM;
        u.pm = fm + ((wgid % nig) % gsz); u.pn = (wgid % nig) / gsz; return true;
    }
};
template <class Epi>
__device__ __forceinline__ void gemm_phase(PG8_LAS unsigned char* lds, const Gemm g, const StaticOrder& S, const Epi& E, int wv) {
    const int tid = otid(wv), wid = __builtin_amdgcn_readfirstlane(tid >> 6), lane = tid & 63, wr = wid >> 2, wc = wid & 3, fr = lane & 15, fq = lane >> 4;
    const int K = g.K, nt = K / BK;
    unsigned voffA[2], voffB[2];
#pragma unroll
    for (int i = 0; i < 2; ++i) { int R, C; stage_rc(tid * 16 + i * 8192, R, C); const int Rb = Epi::PERM ? ((R & ~31) + perm32(R & 31)) : R;
        voffA[i] = (unsigned)(R * K + C) * 2u; voffB[i] = (unsigned)(Rb * K + C) * 2u; }
    const size_t kstep = (size_t)(BK * 2);
    const size_t hstep = (size_t)HALF * K * 2;
    const size_t tstep = 2 * hstep;
    const unsigned ldsw = (unsigned)wid * 1024u;
    const int aoff = lds_byte(wr * 64 + fr, fq * 8), boff = lds_byte(wc * 32 + fr, fq * 8);
#define PG8_SA(b, h) (((b) * 2 + (h)) * HTB)
#define PG8_SB(b, h) ((4 + (b) * 2 + (h)) * HTB)
#define PG8_STAGE(bufoff, gbase, voff) do { _Pragma("unroll") for (int _i = 0; _i < 2; ++_i) \
        __builtin_amdgcn_global_load_lds((const unsigned*)((const char*)(gbase) + (voff)[_i]), (PG8_LAS unsigned*)(lds + (bufoff) + ldsw + _i * 8192), 16, 0, 0); } while (0)
#define PG8_LDA(dst, b, h) do { _Pragma("unroll") for (int m = 0; m < 4; ++m) _Pragma("unroll") for (int k = 0; k < 2; ++k) dst[m][k] = *(const PG8_LAS bf16x8*)(lds + PG8_SA(b, h) + aoff + m * 2048 + k * 1024); } while (0)
#define PG8_LDB(dst, b, h) do { _Pragma("unroll") for (int n = 0; n < 2; ++n) _Pragma("unroll") for (int k = 0; k < 2; ++k) dst[n][k] = *(const PG8_LAS bf16x8*)(lds + PG8_SB(b, h) + boff + n * 2048 + k * 1024); } while (0)
#define PG8_MMA(ai, bj, At, Bt) do { __builtin_amdgcn_s_setprio(1); _Pragma("unroll") for (int m = 0; m < 4; ++m) _Pragma("unroll") for (int n = 0; n < 2; ++n) _Pragma("unroll") for (int k = 0; k < 2; ++k) \
        acc[ai][bj][m][n] = __builtin_amdgcn_mfma_f32_16x16x32_bf16(Bt[n][k], At[m][k], acc[ai][bj][m][n], 0, 0, 0); __builtin_amdgcn_s_setprio(0); } while (0)
#define PG8_WAIT_V(n) asm volatile("s_waitcnt vmcnt(" #n ")" ::: "memory")
#define PG8_WAIT_L(n) asm volatile("s_waitcnt lgkmcnt(" #n ")" ::: "memory")
#define PG8_BAR __builtin_amdgcn_s_barrier()
#define PG8_SCHED __builtin_amdgcn_sched_barrier(0)
    Unit cur, nxt; int ui = 0;
    if (!S.next(0, cur)) return;
    f32x4 acc[2][2][4][2];
#pragma unroll
    for (int a = 0; a < 2; ++a)
#pragma unroll
        for (int b = 0; b < 2; ++b)
#pragma unroll
            for (int m = 0; m < 4; ++m)
#pragma unroll
                for (int n = 0; n < 2; ++n) acc[a][b][m][n] = (f32x4){0.f, 0.f, 0.f, 0.f};
    bf16x8 At[4][2], B0[2][2], B1[2][2];
    float hk[8];
    const char* cA = (const char*)g.A + (size_t)cur.pm * tstep; const char* cB = (const char*)g.Bt + (size_t)cur.pn * tstep;
    PG8_STAGE(PG8_SB(0, 0), cB, voffB); PG8_STAGE(PG8_SA(0, 0), cA, voffA); PG8_STAGE(PG8_SB(0, 1), cB + hstep, voffB); PG8_STAGE(PG8_SA(0, 1), cA + hstep, voffA);
    if (wr == 1) PG8_BAR;
    PG8_WAIT_V(4); PG8_BAR;
    PG8_STAGE(PG8_SB(1, 0), cB + kstep, voffB); PG8_STAGE(PG8_SA(1, 0), cA + kstep, voffA); PG8_STAGE(PG8_SB(1, 1), cB + hstep + kstep, voffB);
    PG8_WAIT_V(6); PG8_BAR;
    for (;;) {
        const bool has_next = S.next(ui + 1, nxt);
        const char* nA = has_next ? (const char*)g.A + (size_t)nxt.pm * tstep : cA; const char* nB = has_next ? (const char*)g.Bt + (size_t)nxt.pn * tstep : cB;
        constexpr int NSEG = Epi::HOOKS ? 3 : 1;
#pragma unroll
        for (int seg = 0; seg < NSEG; ++seg) {
        int tb = 0, te = nt;
        if constexpr (Epi::HOOKS) { tb = (seg == 0) ? 0 : (seg == 1 ? Epi::T1 : Epi::T2); te = (seg == 0) ? Epi::T1 : (seg == 1 ? Epi::T2 : nt);
            if (seg == 1) { PG8_SCHED; E.hook1(acc, hk, cur, wr, lane); PG8_SCHED; } if (seg == 2) { PG8_SCHED; E.hook2(acc, hk); PG8_SCHED; } }
        for (int t = tb; t < te; t += 2) {
            const bool last = (t == nt - 2);
            const char* a1 = cA + (size_t)(t + 1) * kstep;
            const char* a2 = last ? nA : cA + (size_t)(t + 2) * kstep; const char* b2 = last ? nB : cB + (size_t)(t + 2) * kstep;
            const char* a3 = a2 + kstep; const char* b3 = b2 + kstep;
            PG8_LDB(B0, 0, 0); PG8_SCHED; PG8_LDA(At, 0, 0); PG8_STAGE(PG8_SA(1, 1), a1 + hstep, voffA);
            PG8_WAIT_L(8); PG8_BAR; PG8_WAIT_L(0); PG8_MMA(0, 0, At, B0); PG8_BAR; PG8_SCHED;
            PG8_LDB(B1, 0, 1); PG8_STAGE(PG8_SB(0, 0), b2, voffB);
            PG8_BAR; PG8_WAIT_L(0); PG8_MMA(0, 1, At, B1); PG8_BAR;
            PG8_LDA(At, 0, 1); PG8_STAGE(PG8_SA(0, 0), a2, voffA);
            PG8_BAR; PG8_WAIT_L(0); PG8_MMA(1, 0, At, B0); PG8_BAR; PG8_SCHED;
            PG8_STAGE(PG8_SB(0, 1), b2 + hstep, voffB);
            PG8_WAIT_V(6); PG8_BAR; PG8_MMA(1, 1, At, B1); PG8_BAR;
            PG8_LDB(B0, 1, 0); PG8_SCHED; PG8_LDA(At, 1, 0); PG8_STAGE(PG8_SA(0, 1), a2 + hstep, voffA);
            PG8_WAIT_L(8); PG8_BAR; PG8_WAIT_L(0); PG8_MMA(0, 0, At, B0); PG8_BAR; PG8_SCHED;
            PG8_LDB(B1, 1, 1); PG8_STAGE(PG8_SB(1, 0), b3, voffB);
            PG8_BAR; PG8_WAIT_L(0); PG8_MMA(0, 1, At, B1); PG8_BAR;
            PG8_LDA(At, 1, 1); PG8_STAGE(PG8_SA(1, 0), a3, voffA);
            PG8_BAR; PG8_WAIT_L(0); PG8_MMA(1, 0, At, B0); PG8_BAR; PG8_SCHED;
            PG8_STAGE(PG8_SB(1, 1), b3 + hstep, voffB);
            PG8_WAIT_V(6); PG8_BAR; PG8_MMA(1, 1, At, B1); PG8_BAR;
        }
        }
        E(acc, cur, wr, wc, fr, fq);
        if (!has_next) break;
#pragma unroll
        for (int a = 0; a < 2; ++a)
#pragma unroll
            for (int b = 0; b < 2; ++b)
#pragma unroll
                for (int m = 0; m < 4; ++m)
#pragma unroll
                    for (int n = 0; n < 2; ++n) acc[a][b][m][n] = (f32x4){0.f, 0.f, 0.f, 0.f};
        cur = nxt; cA = nA; cB = nB; ++ui;
    }
    PG8_WAIT_V(0);
    if (wr == 0) PG8_BAR;
    PG8_BAR;
#undef PG8_SA
#undef PG8_SB
#undef PG8_STAGE
#undef PG8_LDA
#undef PG8_LDB
#undef PG8_MMA
#undef PG8_WAIT_V
#undef PG8_WAIT_L
#undef PG8_BAR
#undef PG8_SCHED
}

struct EpiBf16Store {
    static constexpr bool PERM = true; static constexpr bool HOOKS = false;
    bf16_t* O; int ldc;
    __device__ __forceinline__ void operator()(const f32x4 (&acc)[2][2][4][2], const Unit& u, int wr, int wc, int fr, int fq) const {
        const int row0 = u.pm * BM + wr * 64 + fr, col0 = u.pn * BM + wc * 32 + 8 * fq;
#pragma unroll
        for (int ai = 0; ai < 2; ++ai)
#pragma unroll
            for (int m = 0; m < 4; ++m) { bf16_t* rowp = O + (size_t)(row0 + ai * HALF + m * 16) * ldc + col0;
#pragma unroll
                for (int bj = 0; bj < 2; ++bj) { const f32x4 v0 = acc[ai][bj][m][0], v1 = acc[ai][bj][m][1];
                    u32x4 w; w.x = cvt_pk_bf16(v0[0], v0[1]); w.y = cvt_pk_bf16(v0[2], v0[3]); w.z = cvt_pk_bf16(v1[0], v1[1]); w.w = cvt_pk_bf16(v1[2], v1[3]);
                    *(u32x4*)(rowp + bj * HALF) = w; } }
    }
};
struct EpiResF32 {
    static constexpr bool PERM = false; static constexpr bool HOOKS = false;
    const float* in; float* out;
    __device__ __forceinline__ void operator()(const f32x4 (&acc)[2][2][4][2], const Unit& u, int wr, int wc, int fr, int fq) const {
        const int row0 = u.pm * BM + wr * 64 + fr, col0 = u.pn * BM + wc * 32 + 4 * fq;
#pragma unroll
        for (int ai = 0; ai < 2; ++ai)
#pragma unroll
            for (int m = 0; m < 4; ++m) { const size_t ro = (size_t)(row0 + ai * HALF + m * 16) * D_MODEL + col0;
#pragma unroll
                for (int bj = 0; bj < 2; ++bj)
#pragma unroll
                    for (int n = 0; n < 2; ++n) { const f32x4 r = *(const f32x4*)(in + ro + bj * HALF + n * 16); *(f32x4*)(out + ro + bj * HALF + n * 16) = r + acc[ai][bj][m][n]; } }
    }
};
template <bool LAST> struct EpiGate {
    static constexpr bool PERM = false; static constexpr bool HOOKS = false;
    const bf16_t* h1; const bf16_t* pp; const float* ssq_in; void* out;
    __device__ __forceinline__ void operator()(const f32x4 (&acc)[2][2][4][2], const Unit& u, int wr, int wc, int fr, int fq) const {
        int lx = fr | (fq << 4); asm volatile("" : "+v"(lx));
        const int frx = lx & 15, fqx = lx >> 4;
        const int row0 = u.pm * BM + wr * 64 + frx, col0 = u.pn * BM + wc * 32 + 4 * fqx;
#pragma unroll
        for (int ai = 0; ai < 2; ++ai) {
            float rs[4];
#pragma unroll
            for (int m = 0; m < 4; ++m) { const float* sp = ssq_in + ((row0 + ai * HALF + m * 16) * 32 + fqx * 8); const f32x4 a = *(const f32x4*)sp, b = *(const f32x4*)(sp + 4);
                float t = ((a[0] + a[1]) + (a[2] + a[3])) + ((b[0] + b[1]) + (b[2] + b[3])); t += __shfl_xor(t, 16); t += __shfl_xor(t, 32); rs[m] = rsqrtf(t * (1.f / 2048.f) + EPS); }
#pragma unroll
            for (int m = 0; m < 4; ++m) { const size_t ro = (size_t)(row0 + ai * HALF + m * 16) * D_MODEL + col0; const float rr = rs[m];
#pragma unroll
                for (int bj = 0; bj < 2; ++bj)
#pragma unroll
                    for (int n = 0; n < 2; ++n) { const size_t o = ro + bj * HALF + n * 16; const u32x2 hw = *(const u32x2*)(h1 + o); const u32x2 pw = *(const u32x2*)(pp + o);
                        const f32x4 a = acc[ai][bj][m][n] * rr; f32x4 v;
                        v[0] = bflo(hw.x) + sigmoidf(a[0]) * bflo(pw.x); v[1] = bfhi(hw.x) + sigmoidf(a[1]) * bfhi(pw.x); v[2] = bflo(hw.y) + sigmoidf(a[2]) * bflo(pw.y); v[3] = bfhi(hw.y) + sigmoidf(a[3]) * bfhi(pw.y);
                        if constexpr (LAST) *(f32x4*)((float*)out + o) = v;
                        else { u32x2 w; w.x = cvt_pk_bf16(v[0], v[1]); w.y = cvt_pk_bf16(v[2], v[3]); *(u32x2*)((bf16_t*)out + o) = w; } } } }
    }
};
struct EpiKV {
    static constexpr bool PERM = true; static constexpr bool HOOKS = false;
    bf16_t* Kb; bf16_t* KV; const float* kn_g; PG8_LAS float* xl;
    __device__ __forceinline__ void operator()(const f32x4 (&acc)[2][2][4][2], const Unit& u, int wr, int wc, int fr, int fq) const {
        const int rl0 = wr * 64 + fr, c0 = wc * 32 + 8 * fq, h = u.pn;
#pragma unroll
        for (int ai = 0; ai < 2; ++ai)
#pragma unroll
            for (int m = 0; m < 4; ++m) { const f32x4 a = acc[ai][0][m][0], b = acc[ai][0][m][1];
                float s = (a[0] * a[0] + a[1] * a[1]) + (a[2] * a[2] + a[3] * a[3]) + (b[0] * b[0] + b[1] * b[1]) + (b[2] * b[2] + b[3] * b[3]);
                s += __shfl_xor(s, 16); s += __shfl_xor(s, 32);
                if (fq == 0) xl[(ai * HALF + rl0 + m * 16) * 4 + wc] = s; }
        asm volatile("s_waitcnt lgkmcnt(0)" ::: "memory"); __builtin_amdgcn_s_barrier(); asm volatile("" ::: "memory");
        float g[8];
        { const f32x4 g0 = *(const f32x4*)(kn_g + c0), g1 = *(const f32x4*)(kn_g + c0 + 4);
#pragma unroll
          for (int j = 0; j < 4; ++j) { g[j] = g0[j]; g[4 + j] = g1[j]; } }
#pragma unroll
        for (int ai = 0; ai < 2; ++ai)
#pragma unroll
            for (int m = 0; m < 4; ++m) { const int rl = ai * HALF + rl0 + m * 16; const f32x4 p = *(const PG8_LAS f32x4*)(xl + rl * 4);
                const float rs = rsqrtf(((p[0] + p[1]) + (p[2] + p[3])) * (1.f / 128.f) + EPS);
                const int t = u.pm * BM + rl, b = t / SEQ, sq = t - b * SEQ;
                const f32x4 k0 = acc[ai][0][m][0] * rs, k1 = acc[ai][0][m][1] * rs, v0 = acc[ai][1][m][0], v1 = acc[ai][1][m][1];
                u32x4 w; w.x = cvt_pk_bf16(k0[0] * g[0], k0[1] * g[1]); w.y = cvt_pk_bf16(k0[2] * g[2], k0[3] * g[3]); w.z = cvt_pk_bf16(k1[0] * g[4], k1[1] * g[5]); w.w = cvt_pk_bf16(k1[2] * g[6], k1[3] * g[7]);
                *(u32x4*)(Kb + ((size_t)(b * 8 + h) * SEQ + sq) * 192 + c0) = w;
                u32x4 x; x.x = cvt_pk_bf16(v0[0], v0[1]); x.y = cvt_pk_bf16(v0[2], v0[3]); x.z = cvt_pk_bf16(v1[0], v1[1]); x.w = cvt_pk_bf16(v1[2], v1[3]);
                *(u32x4*)(KV + (size_t)t * 2048 + h * 256 + 128 + c0) = x; }
    }
};
template <bool IN_BF16> struct EpiResMid {
    static constexpr bool PERM = false; static constexpr bool HOOKS = true; static constexpr int T1 = 16, T2 = 24;
    const void* in; const float* ssqa; const float* ssqc;
    bf16_t* hb; float* ssq2;
    __device__ __forceinline__ void hook1(f32x4 (&acc)[2][2][4][2], float (&hk)[8], const Unit& u, int wr, int fr) const {
        int frx = fr; asm volatile("" : "+v"(frx));
        const int row0 = u.pm * BM + wr * 64 + (frx & 15), fq = (frx >> 4) & 3;
        typedef float f32x2 __attribute__((ext_vector_type(2)));
#pragma unroll
        for (int ai = 0; ai < 2; ++ai) {
            float cs[4], as_[4];
#pragma unroll
            for (int m = 0; m < 4; ++m) { const int row = row0 + ai * HALF + m * 16; const f32x2 c = *(const f32x2*)(ssqc + (row * 8 + fq * 2)); cs[m] = c.x + c.y; as_[m] = ssqa[row * 4 + fq]; }
#pragma unroll
            for (int m = 0; m < 4; ++m) { cs[m] += __shfl_xor(cs[m], 16); cs[m] += __shfl_xor(cs[m], 32); as_[m] += __shfl_xor(as_[m], 16); as_[m] += __shfl_xor(as_[m], 32); }
#pragma unroll
            for (int m = 0; m < 4; ++m) {
                const float rsC = rsqrtf(cs[m] * (1.f / 1024.f) + EPS); const float sA = as_[m] * (1.f / 512.f) + EPS; const float rsA = rsqrtf(sA);
                hk[ai * 4 + m] = rsA; const float f = rsC * sA * rsA;
#pragma unroll
                for (int bj = 0; bj < 2; ++bj)
#pragma unroll
                    for (int n = 0; n < 2; ++n) acc[ai][bj][m][n] = acc[ai][bj][m][n] * f; }
            __builtin_amdgcn_sched_barrier(0);
        }
    }
    __device__ __forceinline__ void hook2(f32x4 (&acc)[2][2][4][2], const float (&hk)[8]) const {
#pragma unroll
        for (int ai = 0; ai < 2; ++ai)
#pragma unroll
            for (int m = 0; m < 4; ++m)
#pragma unroll
                for (int bj = 0; bj < 2; ++bj)
#pragma unroll
                    for (int n = 0; n < 2; ++n) acc[ai][bj][m][n] = acc[ai][bj][m][n] * hk[ai * 4 + m];
    }
    __device__ __forceinline__ void operator()(const f32x4 (&acc)[2][2][4][2], const Unit& u, int wr, int wc, int fr, int fq) const {
        const int row0 = u.pm * BM + wr * 64 + fr, col0 = u.pn * BM + wc * 32 + 4 * fq;
#pragma unroll
        for (int ai = 0; ai < 2; ++ai)
#pragma unroll
            for (int m = 0; m < 4; ++m) { const int row = row0 + ai * HALF + m * 16; const size_t ro = (size_t)row * D_MODEL + col0; float ss = 0.f;
#pragma unroll
                for (int bj = 0; bj < 2; ++bj)
#pragma unroll
                    for (int n = 0; n < 2; ++n) { const size_t o = ro + bj * HALF + n * 16; f32x4 r;
                        if constexpr (IN_BF16) { const u32x2 w = *(const u32x2*)((const bf16_t*)in + o); r = (f32x4){bflo(w.x), bfhi(w.x), bflo(w.y), bfhi(w.y)}; }
                        else r = *(const f32x4*)((const float*)in + o);
                        const f32x4 v = r + acc[ai][bj][m][n];
                        u32x2 w; w.x = cvt_pk_bf16(v[0], v[1]); w.y = cvt_pk_bf16(v[2], v[3]); *(u32x2*)(hb + o) = w; ss += (v[0] * v[0] + v[1] * v[1]) + (v[2] * v[2] + v[3] * v[3]); }
                ss += __shfl_xor(ss, 16); ss += __shfl_xor(ss, 32);
                if (fq == 0) ssq2[row * 32 + u.pn * 4 + wc] = ss; }
    }
};
}


#define XB_TMO      128
#define XB_XCNT(j)  (256  + 64 * (j))
#define XB_XSUB(j)  (1280 + 64 * (j))
#define XB_XGEN(j)  (2304 + 64 * (j))
#define XB_TOP      3328
#define XB_TOPGEN   3392
#define XCD_BAR_WORDS 3456
#define XB_SPIN_CAP (1u << 22)
__device__ __forceinline__ unsigned xb_ld(unsigned* p)              { return __hip_atomic_load(p, __ATOMIC_RELAXED, __HIP_MEMORY_SCOPE_AGENT); }
__device__ __forceinline__ unsigned xb_add(unsigned* p, unsigned v) { return __hip_atomic_fetch_add(p, v, __ATOMIC_RELAXED, __HIP_MEMORY_SCOPE_AGENT); }
__device__ __forceinline__ unsigned xb_xcc_id() { return (unsigned)__builtin_amdgcn_s_getreg((3 << 11) | 20) & 0xFu; }
#define XB_SPIN(cond, bar) do { unsigned _sp = 0; while (cond) { __builtin_amdgcn_s_sleep(1); \
    if ((++_sp & 255u) == 0u) { if (xb_ld(&(bar)[XB_TMO])) break; if (_sp > XB_SPIN_CAP) { atomicAdd(&(bar)[XB_TMO], 1u); break; } } } } while (0)
struct XcdBarrier { unsigned* bar; unsigned x; volatile PG8_LAS unsigned* st; };
__device__ __forceinline__ XcdBarrier xcd_barrier_post(unsigned* bar, volatile PG8_LAS unsigned* st, int wv) {
    XcdBarrier b; b.bar = bar; b.x = xb_xcc_id(); b.st = st;
    if (otid(wv) == 0) (void)xb_add(&bar[XB_XCNT(b.x)], 1u);
    return b;
}
__device__ __forceinline__ void xcd_barrier_complete(unsigned* bar, unsigned x, unsigned& nloc, unsigned& nx) {
    const unsigned G = gridDim.x * gridDim.y * gridDim.z;
    unsigned sum, cnt, mine, sp = 0u;
    for (;;) {
        sum = 0u; cnt = 0u; mine = 0u;
#pragma unroll
        for (unsigned j = 0; j < 16; ++j) { const unsigned c = xb_ld(&bar[XB_XCNT(j)]); sum += c; cnt += (c > 0u) ? 1u : 0u; mine = (j == x) ? c : mine; }
        if (sum == G) break;
        __builtin_amdgcn_s_sleep(1);
        if ((++sp & 255u) == 0u) { if (xb_ld(&bar[XB_TMO])) break; if (sp > XB_SPIN_CAP) { atomicAdd(&bar[XB_TMO], 1u); break; } }
    }
    nloc = mine > 0u ? mine : 1u; nx = cnt > 0u ? cnt : 1u;
}
__device__ __forceinline__ void xcd_barrier(const XcdBarrier& b, int wv) {
    asm volatile("s_waitcnt vmcnt(0)" ::: "memory");
    __syncthreads();
    if (otid(wv) == 0) {
        unsigned* bar = b.bar;
        __builtin_amdgcn_s_waitcnt(0);
        unsigned nloc = b.st[0], nx = b.st[1];
        if (nloc == 0u) { xcd_barrier_complete(bar, b.x, nloc, nx); b.st[0] = nloc; b.st[1] = nx; }
        const unsigned old = xb_add(&bar[XB_XSUB(b.x)], 1u);
        const unsigned gen = old / nloc;
        if (old + 1u == (gen + 1u) * nloc) {
            __builtin_amdgcn_fence(__ATOMIC_RELEASE, "agent");
            asm volatile("s_waitcnt vmcnt(0)" ::: "memory");
            const unsigned og = xb_add(&bar[XB_TOP], 1u);
            const unsigned tg = og / nx;
            if (og + 1u == (tg + 1u) * nx) xb_add(&bar[XB_TOPGEN], 1u);
            else XB_SPIN(xb_ld(&bar[XB_TOPGEN]) == tg, bar);
            __builtin_amdgcn_fence(__ATOMIC_ACQUIRE, "agent");
            xb_add(&bar[XB_XGEN(b.x)], 1u);
            asm volatile("s_waitcnt vmcnt(0)" ::: "memory");
        } else {
            XB_SPIN(xb_ld(&bar[XB_XGEN(b.x)]) == gen, bar);
            __builtin_amdgcn_fence(__ATOMIC_ACQUIRE, "agent");
            asm volatile("s_waitcnt vmcnt(0)" ::: "memory");
        }
    }
    __syncthreads();
}

namespace att {
constexpr int QPARK_OFF = 8 * 128 * 64 * 2 + 16 + 4096;
constexpr int DQ = 192, NW = 8, QBLK = 32, KVBLK = 64;
constexpr float SCALE = 0.07216878364870322f;
constexpr float THR = 8.f;
constexpr int LDQ = 192, LDK = 192, LDV = 2048;
constexpr int SHM_V = KVBLK * 128 * 2, SHM_K = KVBLK * DQ * 2, OFF_K = 3 * SHM_V, OFF_W = OFF_K + 3 * SHM_K, SHM_ATTN = OFF_W + NW * 64 * 4, NQREG = 12, SHM_QPARK = (12 - NQREG) * 512 * 16;
#define KSWZ(row, colB) ((row) * 384 + ((colB) ^ ((((row) >> 1) & 7) << 4)))
#define SBAR() __builtin_amdgcn_sched_barrier(0)
__device__ __forceinline__ int crow(int r, int hi) { return (r & 3) + 8 * (r >> 2) + 4 * hi; }
__device__ __forceinline__ void partialSM(f32x16& p0, f32x16& p1, float& m_reg, float& mn, float& alpha) {
    constexpr float C = SCALE * 1.4426950408889634f;
    float pmax = p0[0];
#pragma unroll
    for (int r = 1; r < 16; ++r) pmax = fmaxf(pmax, p0[r]);
#pragma unroll
    for (int r = 0; r < 16; ++r) pmax = fmaxf(pmax, p1[r]);
    { auto rr = __builtin_amdgcn_permlane32_swap(__float_as_uint(pmax), __float_as_uint(pmax), false, false);
      pmax = fmaxf(__uint_as_float(rr[0]), __uint_as_float(rr[1])); }
    if (__builtin_expect(__all(pmax - m_reg <= THR / SCALE), 1)) { mn = m_reg; alpha = 1.f; }
    else { mn = fmaxf(m_reg, pmax); alpha = __builtin_amdgcn_exp2f((m_reg - mn) * C); m_reg = mn; }
    float mnC = -mn * C;
#pragma unroll
    for (int r = 0; r < 16; ++r) p0[r] = fmaf(p0[r], C, mnC);
#pragma unroll
    for (int r = 0; r < 16; ++r) p1[r] = fmaf(p1[r], C, mnC);
#pragma unroll
    for (int r = 0; r < 16; ++r) p0[r] = __builtin_amdgcn_exp2f(p0[r]);
}
__device__ __forceinline__ void finishSM(f32x16& p0, f32x16& p1, float alpha, float& l_reg, bf16x8& pa0, bf16x8& pa1, bf16x8& pa2, bf16x8& pa3) {
#pragma unroll
    for (int r = 0; r < 16; ++r) p1[r] = __builtin_amdgcn_exp2f(p1[r]);
    float ps = 0;
#pragma unroll
    for (int r = 0; r < 16; ++r) ps += p0[r];
#pragma unroll
    for (int r = 0; r < 16; ++r) ps += p1[r];
    { auto rr = __builtin_amdgcn_permlane32_swap(__float_as_uint(ps), __float_as_uint(ps), false, false);
      ps = __uint_as_float(rr[0]) + __uint_as_float(rr[1]); }
    l_reg = l_reg * alpha + ps;
#define PK4(P, BASE, OUT) do { unsigned a0 = cvt_pk_bf16(P[BASE + 0], P[BASE + 1]), a1 = cvt_pk_bf16(P[BASE + 2], P[BASE + 3]);   \
    unsigned b0 = cvt_pk_bf16(P[BASE + 4], P[BASE + 5]), b1 = cvt_pk_bf16(P[BASE + 6], P[BASE + 7]);                              \
    auto r0 = __builtin_amdgcn_permlane32_swap(a0, b0, false, false); auto r1 = __builtin_amdgcn_permlane32_swap(a1, b1, false, false); \
    u32x4 w = {r0[0], r1[0], r0[1], r1[1]}; OUT = *reinterpret_cast<bf16x8*>(&w); } while (0)
    PK4(p0, 0, pa0); PK4(p0, 8, pa1); PK4(p1, 0, pa2); PK4(p1, 8, pa3);
#undef PK4
}
template <int OFF> __device__ __forceinline__ bf16x8 k_read(int a) { bf16x8 r; asm volatile("ds_read_b128 %0, %1 offset:%2" : "=&v"(r) : "v"(a), "i"(OFF) : "memory"); return r; }
constexpr int KDEPTH = 3;
template <int D0> __device__ __forceinline__ void k_pair(bf16x8& b0, bf16x8& b1, const int* ka) { b0 = k_read<(D0 >> 2) * 128>(ka[D0 & 3]); b1 = k_read<(D0 >> 2) * 128 + 32 * 384>(ka[D0 & 3]); }
template <int N> __device__ __forceinline__ void lgkm_wait(bf16x8& a, bf16x8& b) { asm volatile("s_waitcnt lgkmcnt(%2)" : "+v"(a), "+v"(b) : "n"(N) : "memory"); }
template <int D0> __device__ __forceinline__ void qkt_step(f32x16& p0, f32x16& p1, const bf16x8* qr, const int* ka, bf16x8 (&f0)[4], bf16x8 (&f1)[4]) {
    if constexpr (D0 + KDEPTH < 12) k_pair<D0 + KDEPTH>(f0[(D0 + KDEPTH) & 3], f1[(D0 + KDEPTH) & 3], ka);
    constexpr int younger = ((11 - D0) < KDEPTH ? (11 - D0) : KDEPTH) * 2;
    lgkm_wait<younger>(f0[D0 & 3], f1[D0 & 3]);
    __builtin_amdgcn_s_setprio(1);
    p0 = __builtin_amdgcn_mfma_f32_32x32x16_bf16(f0[D0 & 3], qr[D0], p0, 0, 0, 0);
    p1 = __builtin_amdgcn_mfma_f32_32x32x16_bf16(f1[D0 & 3], qr[D0], p1, 0, 0, 0);
    __builtin_amdgcn_s_setprio(0);
}
__device__ __forceinline__ void qkt(f32x16& p0, f32x16& p1, int kbase, const bf16x8* qr, const int* ko, const char*  ) {
    p0 = f32x16{}; p1 = f32x16{};
    int ka[4];
#pragma unroll
    for (int e = 0; e < 4; ++e) ka[e] = kbase + ko[e];
    bf16x8 f0[4], f1[4];
    k_pair<0>(f0[0], f1[0], ka); k_pair<1>(f0[1], f1[1], ka); if constexpr (KDEPTH > 2) k_pair<2>(f0[2], f1[2], ka);
    qkt_step<0>(p0, p1, qr, ka, f0, f1); qkt_step<1>(p0, p1, qr, ka, f0, f1); qkt_step<2>(p0, p1, qr, ka, f0, f1); qkt_step<3>(p0, p1, qr, ka, f0, f1);
    qkt_step<4>(p0, p1, qr, ka, f0, f1); qkt_step<5>(p0, p1, qr, ka, f0, f1); qkt_step<6>(p0, p1, qr, ka, f0, f1); qkt_step<7>(p0, p1, qr, ka, f0, f1);
    qkt_step<8>(p0, p1, qr, ka, f0, f1); qkt_step<9>(p0, p1, qr, ka, f0, f1); qkt_step<10>(p0, p1, qr, ka, f0, f1); qkt_step<11>(p0, p1, qr, ka, f0, f1);
}
__device__ __forceinline__ int v_st(int k, int c) { const int kk = (k & ~0xC) | ((k & 4) << 1) | ((k & 8) >> 1); return ((kk >> 3) * 4 + (c >> 5)) * 512 + ((kk & 7) * 32 + (c & 31)) * 2; }
__device__ __forceinline__ int v_rd_base(int lane) { return ((lane & 3) << 3) | (((lane >> 2) & 3) << 6) | (((lane >> 4) & 1) << 5) | (((lane >> 5) & 1) << 8); }
constexpr int v_rd_off(int d0, int ks, int half) { return d0 * 512 + ks * 4096 + half * 2048; }
template <int OFF> __device__ __forceinline__ s16x4 tr_read(int vb) {
    s16x4 r; asm volatile("ds_read_b64_tr_b16 %0, %1 offset:%2" : "=&v"(r) : "v"(vb), "i"(OFF) : "memory"); return r;
}
struct VFrag { s16x4 l0, h0, l1, h1, l2, h2, l3, h3; };
template <int D0> __device__ __forceinline__ void v_read8(VFrag& f, int vb) {
    f.l0 = tr_read<v_rd_off(D0, 0, 0)>(vb); f.h0 = tr_read<v_rd_off(D0, 0, 1)>(vb); f.l1 = tr_read<v_rd_off(D0, 1, 0)>(vb); f.h1 = tr_read<v_rd_off(D0, 1, 1)>(vb);
    f.l2 = tr_read<v_rd_off(D0, 2, 0)>(vb); f.h2 = tr_read<v_rd_off(D0, 2, 1)>(vb); f.l3 = tr_read<v_rd_off(D0, 3, 0)>(vb); f.h3 = tr_read<v_rd_off(D0, 3, 1)>(vb);
}
__device__ __forceinline__ void pv_mma4(f32x16& od, const VFrag& f, bf16x8 pa0, bf16x8 pa1, bf16x8 pa2, bf16x8 pa3) {
#define PK(L, H) (bf16x8){L[0], L[1], L[2], L[3], H[0], H[1], H[2], H[3]}
    od = __builtin_amdgcn_mfma_f32_32x32x16_bf16(pa0, PK(f.l0, f.h0), od, 0, 0, 0);
    od = __builtin_amdgcn_mfma_f32_32x32x16_bf16(pa1, PK(f.l1, f.h1), od, 0, 0, 0);
    od = __builtin_amdgcn_mfma_f32_32x32x16_bf16(pa2, PK(f.l2, f.h2), od, 0, 0, 0);
    od = __builtin_amdgcn_mfma_f32_32x32x16_bf16(pa3, PK(f.l3, f.h3), od, 0, 0, 0);
#undef PK
}
__device__ __forceinline__ void pv_d0_1(f32x16* o, int vb, bf16x8 pa0, bf16x8 pa1, bf16x8 pa2, bf16x8 pa3) {
    VFrag f;
    v_read8<0>(f, vb); asm volatile("s_waitcnt lgkmcnt(0)" ::: "memory"); SBAR(); pv_mma4(o[0], f, pa0, pa1, pa2, pa3); SBAR();
    v_read8<1>(f, vb); asm volatile("s_waitcnt lgkmcnt(0)" ::: "memory"); SBAR(); pv_mma4(o[1], f, pa0, pa1, pa2, pa3); SBAR();
    v_read8<2>(f, vb); asm volatile("s_waitcnt lgkmcnt(0)" ::: "memory"); SBAR(); pv_mma4(o[2], f, pa0, pa1, pa2, pa3); SBAR();
    v_read8<3>(f, vb); asm volatile("s_waitcnt lgkmcnt(0)" ::: "memory"); SBAR(); pv_mma4(o[3], f, pa0, pa1, pa2, pa3);
}
__device__ __forceinline__ void pv_d0(f32x16* o, int vb, bf16x8 pa0, bf16x8 pa1, bf16x8 pa2, bf16x8 pa3) {
    VFrag fa, fb;
    v_read8<0>(fa, vb); v_read8<1>(fb, vb);
    asm volatile("s_waitcnt lgkmcnt(8)" ::: "memory"); SBAR(); pv_mma4(o[0], fa, pa0, pa1, pa2, pa3); SBAR();
    v_read8<2>(fa, vb);
    asm volatile("s_waitcnt lgkmcnt(8)" ::: "memory"); SBAR(); pv_mma4(o[1], fb, pa0, pa1, pa2, pa3); SBAR();
    v_read8<3>(fb, vb);
    asm volatile("s_waitcnt lgkmcnt(8)" ::: "memory"); SBAR(); pv_mma4(o[2], fa, pa0, pa1, pa2, pa3); SBAR();
    asm volatile("s_waitcnt lgkmcnt(0)" ::: "memory"); SBAR(); pv_mma4(o[3], fb, pa0, pa1, pa2, pa3);
}
__device__ __forceinline__ void attn_body(const bf16_t* __restrict__ Qb, const bf16_t* __restrict__ Kh, const bf16_t* __restrict__ Vh,
                                          const bf16_t* __restrict__ Zb, bf16_t* __restrict__ Yb, float* __restrict__ Sq, int seq, char* lds, int wv) {
    const int tid = otid(wv), wid = __builtin_amdgcn_readfirstlane(tid >> 6), lane = tid & 63, r32 = lane & 31, hi = lane >> 5;
    PG8_LAS char* l3 = (PG8_LAS char*)lds;
    char* V_lds = lds; char* K_lds = lds + OFF_K;
    float* wsl = (float*)(lds + OFF_W) + wid * 64; float* li_l = wsl; float* al_l = wsl + 32;
    float m_reg = -1e30f, l_reg = 0; f32x16 o[4] = {}; bf16x8 qr[NQREG];
    char* qrl = lds + QPARK_OFF + tid * 16;
    const bf16_t* Qw = Qb + (long)(wid * QBLK + r32) * LDQ + hi * 8;
#pragma unroll
    for (int d0 = 0; d0 < NQREG; ++d0) qr[d0] = *reinterpret_cast<const bf16x8*>(Qw + d0 * 16);
#pragma unroll
    for (int d0 = NQREG; d0 < 12; ++d0) *reinterpret_cast<bf16x8*>(qrl + (d0 - NQREG) * 8192) = *reinterpret_cast<const bf16x8*>(Qw + d0 * 16);
    int kg[3], vg[2];
#pragma unroll
    for (int i = 0; i < 3; ++i) { const int p = (wid * 3 + i) * 64 + lane, row = p / 24, cp = p % 24, c = cp ^ ((row >> 1) & 7); kg[i] = row * LDK + c * 8; }
#pragma unroll
    for (int i = 0; i < 2; ++i) { const int sl = (wid * 2 + i) * 64 + lane, kk = ((sl >> 7) << 3) | ((sl >> 2) & 7), c = ((sl >> 5) & 3) * 32 + (sl & 3) * 8;
        const int k = (kk & ~0xC) | ((kk & 4) << 1) | ((kk & 8) >> 1); vg[i] = k * LDV + c; }
    const int vb0 = (int)(uintptr_t)V_lds + v_rd_base(lane);
    const int klds_i = (int)(uintptr_t)K_lds;
    int ko[4];
#pragma unroll
    for (int e = 0; e < 4; ++e) ko[e] = r32 * 384 + (((e * 2 + hi) ^ ((r32 >> 1) & 7)) << 4);
#define KISSUE(tile, buf) do { const bf16_t* Kt_ = Kh + (size_t)(tile) * (KVBLK * LDK); _Pragma("unroll") for (int i_ = 0; i_ < 3; ++i_) \
    __builtin_amdgcn_global_load_lds((const unsigned*)(Kt_ + kg[i_]), (PG8_LAS unsigned*)(l3 + OFF_K + (buf) * SHM_K + (wid * 3 + i_) * 1024), 16, 0, 0); } while (0)
#define VISSUE(tile, buf) do { const bf16_t* Vt_ = Vh + (size_t)(tile) * (KVBLK * LDV); _Pragma("unroll") for (int i_ = 0; i_ < 2; ++i_) \
    __builtin_amdgcn_global_load_lds((const unsigned*)(Vt_ + vg[i_]), (PG8_LAS unsigned*)(l3 + (buf) * SHM_V + (wid * 2 + i_) * 1024), 16, 0, 0); } while (0)
#define WAITV(n) asm volatile("s_waitcnt vmcnt(" #n ")" ::: "memory")
#define WBAR() do { __builtin_amdgcn_s_barrier(); asm volatile("" ::: "memory"); } while (0)
#define NEXT3(x) ((x) == 2 ? 0 : (x) + 1)
#define RESC(a) do { if (__any((a) < 1.f)) { if (hi == 0) al_l[r32] = (a); asm volatile("s_waitcnt lgkmcnt(0)" ::: "memory"); \
    _Pragma("unroll") for (int d = 0; d < 4; ++d) _Pragma("unroll") for (int r = 0; r < 16; ++r) o[d][r] *= al_l[crow(r, hi)]; } } while (0)
    f32x16 pA0, pA1, pB0, pB1; float mnA, mnB, alA, alB; bf16x8 pa0, pa1, pa2, pa3; const int NT = seq / KVBLK;
    WAITV(0);
    KISSUE(0, 0);
    KISSUE(1, 1); VISSUE(0, 0);
    WAITV(5); WBAR();
    KISSUE(2, 2); VISSUE(1, 1);
    qkt(pA0, pA1, klds_i, qr, ko, qrl); partialSM(pA0, pA1, m_reg, mnA, alA);
    int kb = 1, vbi = 0;
    const int half = wid >> 2;
#define STEP_A(PC0, PC1, MNC, ALC, PP0, PP1, ALP) do { \
        SBAR(); qkt(PC0, PC1, klds_i + kb * SHM_K, qr, ko, qrl); \
        finishSM(PP0, PP1, ALP, l_reg, pa0, pa1, pa2, pa3); SBAR(); \
        pv_d0(o, vb0 + vbi * SHM_V, pa0, pa1, pa2, pa3); partialSM(PC0, PC1, m_reg, MNC, ALC); \
        RESC(ALC); kb = NEXT3(kb); vbi = NEXT3(vbi); } while (0)
#define STEP_B(PC0, PC1, MNC, ALC, PP0, PP1, ALP) do { \
        SBAR(); finishSM(PP0, PP1, ALP, l_reg, pa0, pa1, pa2, pa3); SBAR(); \
        qkt(PC0, PC1, klds_i + kb * SHM_K, qr, ko, qrl); SBAR(); \
        partialSM(PC0, PC1, m_reg, MNC, ALC); SBAR(); \
        pv_d0_1(o, vb0 + vbi * SHM_V, pa0, pa1, pa2, pa3); \
        RESC(ALC); kb = NEXT3(kb); vbi = NEXT3(vbi); } while (0)
#define MAINLOOP(STEP) for (int j = 1; j + 1 < NT; j += 2) { \
        WAITV(5); WBAR(); \
        { const int k2 = NEXT3(NEXT3(kb)), v1 = NEXT3(NEXT3(vbi)); KISSUE(j + 2, k2); VISSUE(j + 1, v1); } \
        STEP(pB0, pB1, mnB, alB, pA0, pA1, alA); \
        WAITV(5); WBAR(); \
        { const int k2 = NEXT3(NEXT3(kb)), v1 = NEXT3(NEXT3(vbi)); if (j + 3 < NT) KISSUE(j + 3, k2); VISSUE(j + 2, v1); } \
        STEP(pA0, pA1, mnA, alA, pB0, pB1, alB); }
    (void)half; MAINLOOP(STEP_A)
    WAITV(0); WBAR();
    SBAR(); qkt(pB0, pB1, klds_i + kb * SHM_K, qr, ko, qrl);
    finishSM(pA0, pA1, alA, l_reg, pa0, pa1, pa2, pa3); SBAR();
    pv_d0(o, vb0 + vbi * SHM_V, pa0, pa1, pa2, pa3); partialSM(pB0, pB1, m_reg, mnB, alB);
    RESC(alB);
    vbi = NEXT3(vbi);
    finishSM(pB0, pB1, alB, l_reg, pa0, pa1, pa2, pa3); SBAR();
    pv_d0(o, vb0 + vbi * SHM_V, pa0, pa1, pa2, pa3);
    if (hi == 0) li_l[r32] = l_reg; asm volatile("s_waitcnt lgkmcnt(0)" ::: "memory");
    int er = wid * QBLK + 4 * hi; asm volatile("" : "+v"(er));
#pragma unroll
    for (int r = 0; r < 16; ++r) { const int ro = er + (r & 3) + 8 * (r >> 2); const float rli = __builtin_amdgcn_rcpf(li_l[ro - wid * QBLK]);
        const bf16_t* zp = Zb + ro * LDP + r32; bf16_t* yp = Yb + ro * 2048 + r32; float sq = 0.f;
#pragma unroll
        for (int d0 = 0; d0 < 4; ++d0) { const float z = bf2f(zp[d0 * 32]); const float y = o[d0][r] * rli * silu(z); sq += y * y; yp[d0 * 32] = f2bf(y); }
        sq += __shfl_xor(sq, 1); sq += __shfl_xor(sq, 2); sq += __shfl_xor(sq, 4); sq += __shfl_xor(sq, 8); sq += __shfl_xor(sq, 16);
        if (r32 == 0) Sq[ro * 8] = sq; }
    __syncthreads();
#undef STEP_A
#undef STEP_B
#undef MAINLOOP
#undef KISSUE
#undef VISSUE
#undef WAITV
#undef WBAR
#undef NEXT3
#undef RESC
}
}

struct TrJob { const float* W; const float* gain; bf16_t* Wt; int K, N, Npad, krot; };
__device__ __forceinline__ void tr_load(const TrJob& J, int tile, int tid, f32x4 (&v)[8]) {
    const int ntn = J.Npad / 128, tk = tile / ntn, tn = tile % ntn, k0 = tk * 128, n0 = tn * 128, c4 = (tid & 31) * 4, r0 = tid >> 5;
#pragma unroll
    for (int i = 0; i < 8; ++i) { const int k = k0 + r0 + i * 16; f32x4 x = (f32x4){0.f, 0.f, 0.f, 0.f};
        if (n0 + c4 < J.N) { x = *(const f32x4*)(J.W + (size_t)k * J.N + n0 + c4); if (J.gain) { const float g = J.gain[k]; x = x * g; } }
        v[i] = x; }
}
constexpr int TR_IN = (2048 / 128) * (LDP / 128), TR_UKV = (512 / 128) * (2048 / 128), TR_SQ = (2048 / 128) * (2048 / 128), TR_PP = (256 / 128) * (2048 / 128);
constexpr int TR_E0 = DEPTH * TR_IN, TR_E1 = TR_E0 + DEPTH * TR_UKV, TR_E2 = TR_E1 + DEPTH * TR_SQ, TR_E3 = TR_E2 + DEPTH * TR_SQ, TR_E4 = TR_E3 + DEPTH * TR_PP;
__device__ __forceinline__ TrJob tr_decode(KPtr P, int g, int& tile) {
    unsigned char* ws = P->ws; TrJob J;
    if (g < TR_E0) { const int l = g / TR_IN; tile = g - l * TR_IN; J = TrJob{P->w_in + (size_t)l * 2048 * IN_W, P->attn_norm + l * 2048, (bf16_t*)(ws + WS_WT_IN) + (size_t)l * LDP * 2048, 2048, IN_W, LDP, 0}; }
    else if (g < TR_E1) { const int q = g - TR_E0, l = q / TR_UKV; tile = q - l * TR_UKV; J = TrJob{P->w_ukv + (size_t)l * 512 * 2048, P->kv_norm + l * 512, (bf16_t*)(ws + WS_WT_UKV) + (size_t)l * 2048 * 512, 512, 2048, 2048, 0}; }
    else if (g < TR_E2) { const int q = g - TR_E1, l = q / TR_SQ; tile = q - l * TR_SQ; J = TrJob{P->w_out + (size_t)l * 2048 * 2048, P->out_norm + l * 2048, (bf16_t*)(ws + WS_WT_OUT) + (size_t)l * 2048 * 2048, 2048, 2048, 2048, 1024}; }
    else if (g < TR_E3) { const int q = g - TR_E2, l = q / TR_SQ; tile = q - l * TR_SQ; J = TrJob{P->w_ple_gate + (size_t)l * 2048 * 2048, P->ple_norm + l * 2048, (bf16_t*)(ws + WS_WT_G) + (size_t)l * 2048 * 2048, 2048, 2048, 2048, 0}; }
    else { const int q = g - TR_E3, l = q / TR_PP; tile = q - l * TR_PP; J = TrJob{P->w_ple_proj + (size_t)l * 256 * 2048, nullptr, (bf16_t*)(ws + WS_WT_PP) + (size_t)l * 2048 * 256, 256, 2048, 2048, 0}; }
    return J;
}
__device__ __forceinline__ void transpose_flat(KPtr P, float* lds, int wv) {
    const int tid = otid(wv);
    int g = blockIdx.x; if (g >= TR_E4) return;
    int tile; TrJob J = tr_decode(P, g, tile);
    f32x4 v[8]; tr_load(J, tile, tid, v);
    for (;;) {
        const int c4 = (tid & 31) * 4, r0 = tid >> 5;
#pragma unroll
        for (int i = 0; i < 8; ++i) { float* d = lds + (r0 + i * 16) * 129 + c4; d[0] = v[i][0]; d[1] = v[i][1]; d[2] = v[i][2]; d[3] = v[i][3]; }
        __syncthreads();
        const TrJob Jc = J; const int cur = tile; g += gridDim.x; const bool more = g < TR_E4;
        if (more) { J = tr_decode(P, g, tile); tr_load(J, tile, tid, v); }
        const int ntn = Jc.Npad / 128, tk = cur / ntn, tn = cur % ntn, k0 = tk * 128, n0 = tn * 128;
#pragma unroll
        for (int j = 0; j < 4; ++j) { const int c = tid + j * 512, kc = c & 15, n = c >> 4; const float* sp = lds + (kc * 8) * 129 + n;
            u32x4 w; w.x = cvt_pk_bf16(sp[0], sp[129]); w.y = cvt_pk_bf16(sp[2 * 129], sp[3 * 129]); w.z = cvt_pk_bf16(sp[4 * 129], sp[5 * 129]); w.w = cvt_pk_bf16(sp[6 * 129], sp[7 * 129]);
            *(u32x4*)(Jc.Wt + (size_t)(n0 + n) * Jc.K + ((k0 + Jc.krot) % Jc.K) + kc * 8) = w; }
        __syncthreads();
        if (!more) break;
    }
}
__device__ void phase_prep(KPtr P, float* lds, int wv) {
    unsigned char* ws = P->ws;
    transpose_flat(P, lds, wv);
    { const size_t n4 = (size_t)DEPTH * T * PLE / 4; const f32x4* src = (const f32x4*)P->p; u32x2* dst = (u32x2*)(ws + WS_PB);
      for (size_t i = (size_t)blockIdx.x * NTHR + otid(wv); i < n4; i += (size_t)gridDim.x * NTHR) { const f32x4 v = src[i]; u32x2 w; w.x = cvt_pk_bf16(v[0], v[1]); w.y = cvt_pk_bf16(v[2], v[3]); dst[i] = w; } }
    { float* cs = (float*)(ws + WS_COS); float* sn = (float*)(ws + WS_SIN);
      for (int i = blockIdx.x * NTHR + otid(wv); i < T * 32; i += gridDim.x * NTHR) { const int t = i >> 5, f = i & 31;
          const double inv = exp(-(double)(2 * f) / 64.0 * 9.210340371976184); const double ang = (double)P->positions[t] * inv; cs[i] = (float)cos(ang); sn[i] = (float)sin(ang); } }
}
__device__ void phase_rownorm_bf(const bf16_t* __restrict__ src, bf16_t* __restrict__ dst, int wv) {
    const int tid = otid(wv), wid = tid >> 6, lane = tid & 63, stride = gridDim.x * 8;
    for (int row = blockIdx.x * 8 + wid; row < T; row += stride) {
        const u32x4* p = (const u32x4*)(src + (size_t)row * 2048); float f[4][8]; float ss = 0.f;
#pragma unroll
        for (int j = 0; j < 4; ++j) { unpack8(p[lane + 64 * j], f[j]);
#pragma unroll
            for (int e = 0; e < 8; ++e) ss += f[j][e] * f[j][e]; }
        ss = wave_sum(ss); const float rs = rsqrtf(ss * (1.f / 2048.f) + EPS);
        u32x4* d = (u32x4*)(dst + (size_t)row * 2048);
#pragma unroll
        for (int j = 0; j < 4; ++j) {
#pragma unroll
            for (int e = 0; e < 8; ++e) f[j][e] *= rs;
            d[lane + 64 * j] = pack8(f[j]); }
    }
}
__device__ void phase_rownorm(const float* __restrict__ src, bf16_t* __restrict__ dst, int wv) {
    const int tid = otid(wv), wid = tid >> 6, lane = tid & 63, stride = gridDim.x * 8;
    int row = blockIdx.x * 8 + wid; f32x4 v[8], nv[8];
    if (row < T) { const f32x4* p = (const f32x4*)(src + (size_t)row * 2048);
#pragma unroll
        for (int j = 0; j < 8; ++j) v[j] = p[lane + 64 * j]; }
    for (; row < T; row += stride) {
        const int rn = row + stride; const bool more = rn < T;
        if (more) { const f32x4* p = (const f32x4*)(src + (size_t)rn * 2048);
#pragma unroll
            for (int j = 0; j < 8; ++j) nv[j] = p[lane + 64 * j]; }
        float ss = 0.f;
#pragma unroll
        for (int j = 0; j < 8; ++j) ss += v[j][0] * v[j][0] + v[j][1] * v[j][1] + v[j][2] * v[j][2] + v[j][3] * v[j][3];
        ss = wave_sum(ss); const float rs = rsqrtf(ss * (1.f / 2048.f) + EPS);
        u32x2* d = (u32x2*)(dst + (size_t)row * 2048);
#pragma unroll
        for (int j = 0; j < 8; ++j) { u32x2 w; w.x = cvt_pk_bf16(v[j][0] * rs, v[j][1] * rs); w.y = cvt_pk_bf16(v[j][2] * rs, v[j][3] * rs); d[lane + 64 * j] = w; }
        if (more) {
#pragma unroll
            for (int j = 0; j < 8; ++j) v[j] = nv[j]; }
    }
}
__device__ void phase_post_rows(KPtr P, int l, int wv) {
    unsigned char* ws = P->ws; const bf16_t* __restrict__ PROJ = (const bf16_t*)(ws + WS_PROJ); bf16_t* __restrict__ Q = (bf16_t*)(ws + WS_Q); bf16_t* __restrict__ Kb = (bf16_t*)(ws + WS_K);
    bf16_t* __restrict__ CK = (bf16_t*)(ws + WS_CKVN); bf16_t* __restrict__ Y = (bf16_t*)(ws + WS_Y); const float* __restrict__ COS = (const float*)(ws + WS_COS); const float* __restrict__ SIN = (const float*)(ws + WS_SIN);
    const int tid = otid(wv), wid = tid >> 6, lane = tid & 63, h = lane >> 3, sub = lane & 7, ch = lane * 8, fi = (sub & 3) * 8;
    float gqn[16], gqr[8], gkr[8], w0[8], w1[8], w2[8], cb[8];
    { const float* qn_g = P->q_nope_norm + l * 128 + sub * 16; const float* qr_g = P->q_rope_norm + l * 64 + sub * 8; const float* kr_g = P->k_rope_norm + l * 64 + sub * 8;
      const float* cw = P->conv_w + (size_t)l * 3 * 512 + ch; const float* cbias = P->conv_b + (size_t)l * 512 + ch;
#pragma unroll
      for (int e = 0; e < 16; ++e) gqn[e] = qn_g[e];
#pragma unroll
      for (int e = 0; e < 8; ++e) { gqr[e] = qr_g[e]; gkr[e] = kr_g[e]; w0[e] = cw[e]; w1[e] = cw[512 + e]; w2[e] = cw[1024 + e]; cb[e] = cbias[e]; } }
    for (int t = blockIdx.x * 8 + wid; t < T; t += gridDim.x * 8) {
        const int b = t / SEQ, s = t % SEQ; const bf16_t* pr = PROJ + (size_t)t * LDP;
        const size_t qo = ((size_t)(b * 8 + h) * SEQ + s) * 192;
        const bool hasm = s > 0, hasp = s < SEQ - 1; const u32x4 zero4 = {0u, 0u, 0u, 0u};
        const u32x4 lqn0 = *(const u32x4*)(pr + OFF_CQ + 192 * h + sub * 16), lqn1 = *(const u32x4*)(pr + OFF_CQ + 192 * h + sub * 16 + 8);
        const u32x4 lqr = *(const u32x4*)(pr + OFF_CQ + 192 * h + 128 + sub * 8), lkr = *(const u32x4*)(pr + OFF_CKR + sub * 8), lkv = *(const u32x4*)(pr + OFF_CKV + ch);
        const u32x4 lbb = *(const u32x4*)(pr + OFF_BB + ch), lc0 = *(const u32x4*)(pr + OFF_BC + ch), lh0 = *(const u32x4*)(pr + OFF_BH + ch), lzz = *(const u32x4*)(pr + OFF_BZ + ch);
        const u32x4 lcm = hasm ? *(const u32x4*)(pr - LDP + OFF_BC + ch) : zero4, lhm = hasm ? *(const u32x4*)(pr - LDP + OFF_BH + ch) : zero4;
        const u32x4 lcp = hasp ? *(const u32x4*)(pr + LDP + OFF_BC + ch) : zero4, lhp = hasp ? *(const u32x4*)(pr + LDP + OFF_BH + ch) : zero4;
        const f32x4 lc0s = *(const f32x4*)(COS + (size_t)t * 32 + fi), lc1s = *(const f32x4*)(COS + (size_t)t * 32 + fi + 4), ls0s = *(const f32x4*)(SIN + (size_t)t * 32 + fi), ls1s = *(const f32x4*)(SIN + (size_t)t * 32 + fi + 4);
        float cs[8], sn[8];
#pragma unroll
        for (int e = 0; e < 4; ++e) { cs[e] = lc0s[e]; cs[4 + e] = lc1s[e]; sn[e] = ls0s[e]; sn[4 + e] = ls1s[e]; }
        {
            float f[16]; unpack8(lqn0, f); unpack8(lqn1, f + 8);
            float ss = 0.f;
#pragma unroll
            for (int e = 0; e < 16; ++e) ss += f[e] * f[e];
            ss = sum8(ss); const float rs = rsqrtf(ss * (1.f / 128.f) + EPS);
#pragma unroll
            for (int e = 0; e < 16; ++e) f[e] = f[e] * rs * gqn[e];
            u32x4* d = (u32x4*)(Q + qo + sub * 16); d[0] = pack8(f); d[1] = pack8(f + 8);
        }
        {
            float f[8]; unpack8(lqr, f);
            float ss = 0.f;
#pragma unroll
            for (int e = 0; e < 8; ++e) ss += f[e] * f[e];
            ss = sum8(ss); const float rs = rsqrtf(ss * (1.f / 64.f) + EPS); float o8[8];
#pragma unroll
            for (int e = 0; e < 8; ++e) { const float xn = f[e] * rs * gqr[e]; const float pt = __shfl_xor(xn, 4);
                o8[e] = (sub < 4) ? (xn * cs[e] - pt * sn[e]) : (xn * cs[e] + pt * sn[e]); }
            *(u32x4*)(Q + qo + 128 + sub * 8) = pack8(o8);
        }
        {
            float f[8]; unpack8(lkr, f);
            float ss = 0.f;
#pragma unroll
            for (int e = 0; e < 8; ++e) ss += f[e] * f[e];
            ss = sum8(ss); const float rs = rsqrtf(ss * (1.f / 64.f) + EPS); float o8[8];
#pragma unroll
            for (int e = 0; e < 8; ++e) { const float xn = f[e] * rs * gkr[e]; const float pt = __shfl_xor(xn, 4);
                o8[e] = (sub < 4) ? (xn * cs[e] - pt * sn[e]) : (xn * cs[e] + pt * sn[e]); }
            *(u32x4*)(Kb + qo + 128 + sub * 8) = pack8(o8);
        }
        {
            float f[8]; unpack8(lkv, f);
            float ss = 0.f;
#pragma unroll
            for (int e = 0; e < 8; ++e) ss += f[e] * f[e];
            ss = wave_sum(ss); const float rs = rsqrtf(ss * (1.f / 512.f) + EPS);
#pragma unroll
            for (int e = 0; e < 8; ++e) f[e] *= rs;
            *(u32x4*)(CK + (size_t)t * 512 + ch) = pack8(f);
        }
        {
            float bb[8], c0[8], h0[8], zz[8], cm[8], hm[8], cp[8], hp[8];
            unpack8(lbb, bb); unpack8(lc0, c0); unpack8(lh0, h0); unpack8(lzz, zz); unpack8(lcm, cm); unpack8(lhm, hm); unpack8(lcp, cp); unpack8(lhp, hp);
            float o8[8]; float ssb = 0.f;
#pragma unroll
            for (int e = 0; e < 8; ++e) { const float y = cb[e] + w0[e] * (cm[e] * hm[e]) + w1[e] * (c0[e] * h0[e]) + w2[e] * (cp[e] * hp[e]);
                o8[e] = bb[e] * y * silu(zz[e]); ssb += o8[e] * o8[e]; }
            ssb = wave_sum(ssb); const float rsb = rsqrtf(ssb * (1.f / 512.f) + EPS);
#pragma unroll
            for (int e = 0; e < 8; ++e) o8[e] *= rsb;
            *(u32x4*)(Y + (size_t)t * 2048 + YB + ch) = pack8(o8);
        }
    }
}
__device__ void phase_sgu(KPtr P, int l, char* lds, int wv) {
    unsigned char* ws = P->ws; const bf16_t* __restrict__ PROJ = (const bf16_t*)(ws + WS_PROJ); bf16_t* __restrict__ Y = (bf16_t*)(ws + WS_Y);
    const int tid = otid(wv), wid = tid >> 6, lane = tid & 63, fr = lane & 15, fq = lane >> 4;
    constexpr int VST = 264;
    for (int unit = blockIdx.x; unit < (T / 128) * 4; unit += gridDim.x) {
        const int k = unit >> 2, h = unit & 3, t0 = k * 128, n0 = wid * 16, t = t0 + n0 + fr;
        bf16_t r0[16], r1[16];
#pragma unroll
        for (int i = 0; i < 16; ++i) { const bf16_t* pv = PROJ + (size_t)(t0 + wid * 16 + i) * LDP + OFF_AV + h * 128; r0[i] = pv[lane]; r1[i] = pv[lane + 64]; }
        const float* sg = P->sgu_norm + (size_t)(l * 4 + h) * 128; const float g0 = sg[lane], g1 = sg[lane + 64];
        const float* wsp = P->w_spatial + ((size_t)(l * 4 + h) * 128 + n0 + fr) * 128 + fq * 8;
        f32x4 wa[4], wc[4];
#pragma unroll
        for (int kk = 0; kk < 4; ++kk) { wa[kk] = *(const f32x4*)(wsp + kk * 32); wc[kk] = *(const f32x4*)(wsp + kk * 32 + 4); }
        const float bias = P->b_spatial[(size_t)(l * 4 + h) * 128 + n0 + fr]; const bf16_t* pr = PROJ + (size_t)t * LDP + h * 128 + fq * 4;
        u32x2 uw[8], zw[8];
#pragma unroll
        for (int ct = 0; ct < 8; ++ct) { uw[ct] = *(const u32x2*)(pr + OFF_AU + ct * 16); zw[ct] = *(const u32x2*)(pr + OFF_AZ + ct * 16); }
#pragma unroll
        for (int i = 0; i < 16; ++i) { const int m = wid * 16 + i;
            const float x0 = bf2f(r0[i]), x1 = bf2f(r1[i]); const float ss = wave_sum(x0 * x0 + x1 * x1); const float rs = rsqrtf(ss * (1.f / 128.f) + EPS);
            *(bf16_t*)(lds + lane * VST + m * 2) = f2bf(x0 * rs * g0); *(bf16_t*)(lds + (lane + 64) * VST + m * 2) = f2bf(x1 * rs * g1); }
        __syncthreads();
        bf16x8 bw[4];
#pragma unroll
        for (int kk = 0; kk < 4; ++kk) { const f32x4 a = wa[kk], c = wc[kk];
            u32x4 w; w.x = cvt_pk_bf16(a[0], a[1]); w.y = cvt_pk_bf16(a[2], a[3]); w.z = cvt_pk_bf16(c[0], c[1]); w.w = cvt_pk_bf16(c[2], c[3]); bw[kk] = *reinterpret_cast<bf16x8*>(&w); }
        f32x4 acc[8];
#pragma unroll
        for (int ct = 0; ct < 8; ++ct) { acc[ct] = (f32x4){0.f, 0.f, 0.f, 0.f};
#pragma unroll
            for (int kk = 0; kk < 4; ++kk) { const char* ap = lds + (ct * 16 + fr) * VST + (kk * 32 + fq * 8) * 2;
                const u32x2 lo = *(const u32x2*)ap, hi2 = *(const u32x2*)(ap + 8); u32x4 w = {lo.x, lo.y, hi2.x, hi2.y};
                acc[ct] = __builtin_amdgcn_mfma_f32_16x16x32_bf16(*reinterpret_cast<bf16x8*>(&w), bw[kk], acc[ct], 0, 0, 0); } }
        float ssa = 0.f;
#pragma unroll
        for (int ct = 0; ct < 8; ++ct) {
            const float v0 = bflo(uw[ct].x) * (acc[ct][0] + bias) * silu(bflo(zw[ct].x)), v1 = bfhi(uw[ct].x) * (acc[ct][1] + bias) * silu(bfhi(zw[ct].x));
            const float v2 = bflo(uw[ct].y) * (acc[ct][2] + bias) * silu(bflo(zw[ct].y)), v3 = bfhi(uw[ct].y) * (acc[ct][3] + bias) * silu(bfhi(zw[ct].y));
            ssa += (v0 * v0 + v1 * v1) + (v2 * v2 + v3 * v3);
            u32x2 w; w.x = cvt_pk_bf16(v0, v1); w.y = cvt_pk_bf16(v2, v3); *(u32x2*)(Y + (size_t)t * 2048 + YA + h * 128 + ct * 16 + fq * 4) = w; }
        ssa += __shfl_xor(ssa, 16); ssa += __shfl_xor(ssa, 32);
        if (fq == 0) ((float*)(ws + WS_SSQA))[(size_t)t * 4 + h] = ssa;
        __syncthreads();
    }
}
__device__ void phase_attn(KPtr P, char* lds, int wv) {
    unsigned char* ws = P->ws; const bf16_t* Q = (const bf16_t*)(ws + WS_Q); const bf16_t* Kb = (const bf16_t*)(ws + WS_K); const bf16_t* KV = (const bf16_t*)(ws + WS_KV);
    const bf16_t* PROJ = (const bf16_t*)(ws + WS_PROJ); bf16_t* Y = (bf16_t*)(ws + WS_Y);
    for (int v = blockIdx.x; v < BATCH * 8 * (SEQ / 256); v += gridDim.x) {
        const int h = v & 7, qb = (v >> 3) & 31, b = v >> 8; const size_t tq = (size_t)b * SEQ + qb * 256;
        att::attn_body(Q + ((size_t)(b * 8 + h) * SEQ + qb * 256) * 192, Kb + (size_t)(b * 8 + h) * SEQ * 192, KV + (size_t)b * SEQ * 2048 + h * 256 + 128,
                       PROJ + tq * LDP + OFF_CZ + h * 128, Y + tq * 2048 + YC + h * 128, (float*)(ws + WS_SSQC) + tq * 8 + h, SEQ, lds, wv);
    }
}

constexpr int LDS_BYTES = pg8::STAGE_BYTES + 16 + 4096 + att::SHM_QPARK;
static_assert(att::QPARK_OFF == pg8::STAGE_BYTES + 16 + 4096 && LDS_BYTES <= 160 * 1024, "LDS map");
static_assert(att::SHM_ATTN <= pg8::STAGE_BYTES, "attention LDS");
__global__ void __launch_bounds__(NTHR, 2) fwd_megakernel(Params P_args) {
    extern __shared__ __attribute__((aligned(16))) unsigned char lds[];
    cg::grid_group grid = cg::this_grid();
    unsigned char* ws = kp_fresh()->ws; const int G = gridDim.x;
    bf16_t* HN = (bf16_t*)(ws + WS_Y); bf16_t* Y = (bf16_t*)(ws + WS_Y); bf16_t* PROJ = (bf16_t*)(ws + WS_PROJ); bf16_t* PPb = (bf16_t*)(ws + WS_PP);
    bf16_t* CK = (bf16_t*)(ws + WS_CKVN); bf16_t* KV = (bf16_t*)(ws + WS_KV); bf16_t* Kb = (bf16_t*)(ws + WS_K);
    PG8_LAS unsigned char* llds = (PG8_LAS unsigned char*)lds;
    volatile PG8_LAS unsigned* bst = (volatile PG8_LAS unsigned*)(llds + pg8::STAGE_BYTES);
    const int wv = __builtin_amdgcn_readfirstlane((int)threadIdx.x >> 6);
    { const int t0_ = otid(wv); if (t0_ < 4) bst[t0_] = 0u; }
    __syncthreads();
    XcdBarrier xb = xcd_barrier_post((unsigned*)(ws + WS_BAR), bst, wv);
#define GSYNC() xcd_barrier(xb, wv)

    phase_prep(kp_fresh(), (float*)lds, wv);
    grid.sync();
    for (int l = 0; l < DEPTH; ++l) {
        bf16_t* H2 = (bf16_t*)(ws + WS_H2);
        if (l == 0) phase_rownorm(kp_fresh()->x, HN, wv); else phase_rownorm_bf(H2, HN, wv);
        GSYNC();
        { pg8::Gemm g{HN, (const bf16_t*)(ws + WS_WT_IN) + (size_t)l * LDP * 2048, T, LDP, 2048}; pg8::StaticOrder S; S.init(T, LDP, G, (int)blockIdx.x);
          pg8::EpiBf16Store E{PROJ, LDP}; pg8::gemm_phase(llds, g, S, E, wv); }
        GSYNC();
        phase_sgu(kp_fresh(), l, (char*)lds, wv);
        phase_post_rows(kp_fresh(), l, wv);
        GSYNC();
        { pg8::Gemm g{CK, (const bf16_t*)(ws + WS_WT_UKV) + (size_t)l * 2048 * 512, T, 2048, 512}; pg8::StaticOrder S; S.init(T, 2048, G, (int)blockIdx.x);
          pg8::EpiKV E{Kb, KV, kp_fresh()->k_nope_norm + l * 128, (PG8_LAS float*)(llds + pg8::STAGE_BYTES + 16)}; pg8::gemm_phase(llds, g, S, E, wv); }
        { pg8::Gemm g{(const bf16_t*)(ws + WS_PB) + (size_t)l * T * 256, (const bf16_t*)(ws + WS_WT_PP) + (size_t)l * 2048 * 256, T, 2048, 256}; pg8::StaticOrder S; S.init(T, 2048, G, (int)blockIdx.x);
          pg8::EpiBf16Store E{PPb, 2048}; pg8::gemm_phase(llds, g, S, E, wv); }
        GSYNC();
        phase_attn(kp_fresh(), (char*)lds, wv);
        GSYNC();
        { pg8::Gemm g{Y, (const bf16_t*)(ws + WS_WT_OUT) + (size_t)l * 2048 * 2048, T, 2048, 2048}; pg8::StaticOrder S; S.init(T, 2048, G, (int)blockIdx.x);
          if (l == 0) { pg8::EpiResMid<false> E{kp_fresh()->x, (const float*)(ws + WS_SSQA), (const float*)(ws + WS_SSQC), (bf16_t*)(ws + WS_KV), (float*)(ws + WS_SSQ2)}; pg8::gemm_phase(llds, g, S, E, wv); }
          else { pg8::EpiResMid<true> E{H2, (const float*)(ws + WS_SSQA), (const float*)(ws + WS_SSQC), (bf16_t*)(ws + WS_KV), (float*)(ws + WS_SSQ2)}; pg8::gemm_phase(llds, g, S, E, wv); } }
        GSYNC();
        { pg8::Gemm g{(const bf16_t*)(ws + WS_KV), (const bf16_t*)(ws + WS_WT_G) + (size_t)l * 2048 * 2048, T, 2048, 2048}; pg8::StaticOrder S; S.init(T, 2048, G, (int)blockIdx.x);
          if (l + 1 < DEPTH) { pg8::EpiGate<false> E{(const bf16_t*)(ws + WS_KV), PPb, (const float*)(ws + WS_SSQ2), H2}; pg8::gemm_phase(llds, g, S, E, wv); }
          else { pg8::EpiGate<true> E{(const bf16_t*)(ws + WS_KV), PPb, (const float*)(ws + WS_SSQ2), kp_fresh()->out}; pg8::gemm_phase(llds, g, S, E, wv); } }
        if (l + 1 < DEPTH) GSYNC();
    }
}

extern "C" void kernel_launch(void* const* d_in, const int* in_sizes, int n_in, void* d_out, int out_size, void* d_ws, size_t ws_size, hipStream_t stream) {
    static int grid_blocks = 0;
    if (grid_blocks == 0) {
        if (n_in != 21 || out_size != T * D_MODEL || ws_size < WS_END) { fprintf(stderr, "kernel_launch: unexpected shapes (n_in %d, out %d, ws %zu need %zu)\n", n_in, out_size, ws_size, (size_t)WS_END); grid_blocks = -1; return; }
        int dev = 0, cus = 0, per_cu = 0;
        hipGetDevice(&dev); hipDeviceGetAttribute(&cus, hipDeviceAttributeMultiprocessorCount, dev);
        if (hipFuncSetAttribute((const void*)fwd_megakernel, hipFuncAttributeMaxDynamicSharedMemorySize, LDS_BYTES) != hipSuccess) { fprintf(stderr, "kernel_launch: hipFuncSetAttribute failed\n"); grid_blocks = -1; return; }
        hipOccupancyMaxActiveBlocksPerMultiprocessor(&per_cu, (const void*)fwd_megakernel, NTHR, LDS_BYTES);
        if (per_cu < 1) { fprintf(stderr, "kernel_launch: occupancy query says %d blocks per CU\n", per_cu); per_cu = 1; }
        if (per_cu > 1) per_cu = 1;
        grid_blocks = cus * per_cu;
    }
    if (grid_blocks < 0) return;
    Params P{};
    P.x = (const float*)d_in[0]; P.p = (const float*)d_in[1]; P.positions = (const int*)d_in[2]; P.attn_norm = (const float*)d_in[3]; P.w_in = (const float*)d_in[4];
    P.sgu_norm = (const float*)d_in[5]; P.w_spatial = (const float*)d_in[6]; P.b_spatial = (const float*)d_in[7]; P.conv_w = (const float*)d_in[8]; P.conv_b = (const float*)d_in[9];
    P.kv_norm = (const float*)d_in[10]; P.w_ukv = (const float*)d_in[11]; P.q_nope_norm = (const float*)d_in[12]; P.q_rope_norm = (const float*)d_in[13];
    P.k_nope_norm = (const float*)d_in[14]; P.k_rope_norm = (const float*)d_in[15]; P.out_norm = (const float*)d_in[16]; P.w_out = (const float*)d_in[17];
    P.ple_norm = (const float*)d_in[18]; P.w_ple_gate = (const float*)d_in[19]; P.w_ple_proj = (const float*)d_in[20]; P.out = (float*)d_out; P.ws = (unsigned char*)d_ws;
    if (hipMemsetAsync((unsigned char*)d_ws + WS_BAR, 0, 16384, stream) != hipSuccess) { fprintf(stderr, "kernel_launch: memset failed\n"); return; }
    void* args[] = {&P};
    hipError_t e = hipLaunchCooperativeKernel((const void*)fwd_megakernel, dim3(grid_blocks), dim3(NTHR), args, LDS_BYTES, stream);
    if (e != hipSuccess) fprintf(stderr, "kernel_launch: cooperative launch failed: %s (grid %d)\n", hipGetErrorString(e), grid_blocks);
}
```
